# Optimizing an MI355X kernel written in HIP

```python
import numpy as np
import jax, jax.numpy as jnp
from jax import lax

D_MODEL = 1024
BATCH = 8
SEQ = 2048
DEPTH = 2

N_A_LAYERS = DEPTH // 2
N_B_LAYERS = DEPTH - N_A_LAYERS
D_FF = 2816
CONV_WIDTH = 3
N_HEADS = 16
HEAD_DIM = D_MODEL // N_HEADS
N_KV_GROUPS = 4
HEADS_PER_GROUP = N_HEADS // N_KV_GROUPS
CMP_BLOCK = 32
CMP_STRIDE = 16
CMP_HIDDEN = 4 * HEAD_DIM
SEL_BLOCK = 64
N_SELECT = 16
WINDOW = 512
N_BRANCH = 3
N_KV_SLOTS = 6
QUERY_CHUNK = 32
EPS = 1e-6
FORCE_SCORE = 1e9
MASK_SCORE = -1e30

kernel_name = "yoco_shortconv_nsa_macaron"


def _rmsnorm(x, g):
    xf = x.astype(jnp.float32)
    y = xf * lax.rsqrt(jnp.mean(xf * xf, axis=-1, keepdims=True) + EPS)
    return (y * g.astype(jnp.float32)).astype(x.dtype)


def _swiglu(x, w_gate_up, w_down):
    a, b = jnp.split(x @ w_gate_up, 2, axis=-1)
    return (jax.nn.silu(a) * b) @ w_down


def _short_conv(x, w_in, conv_w, w_out):
    b_gate, c_gate, u = jnp.split(x @ w_in, 3, axis=-1)
    v = c_gate * u
    conv = lax.conv_general_dilated(
        v, conv_w[:, None, :], window_strides=(1,), padding=[(CONV_WIDTH - 1, 0)],
        dimension_numbers=("NWC", "WIO", "NWC"), feature_group_count=D_MODEL)
    return (b_gate * conv) @ w_out


def _compress(x_raw, pos, w1, b1, w2):
    s = x_raw.shape[2]
    n_cmp = (s - CMP_BLOCK) // CMP_STRIDE + 1
    idx = np.arange(n_cmp)[:, None] * CMP_STRIDE + np.arange(CMP_BLOCK)[None, :]
    blocks = x_raw[:, :, idx] + pos
    flat = blocks.reshape(blocks.shape[:3] + (CMP_BLOCK * HEAD_DIM,))
    return jax.nn.gelu(flat @ w1 + b1) @ w2


def _shared_kv(h, kv_norm, kv_w, cmp_pos, cmp_w1, cmp_b1, cmp_w2, k_norm):
    b, s, _ = h.shape
    kv = (_rmsnorm(h, kv_norm) @ kv_w).reshape(b, s, N_KV_SLOTS, N_KV_GROUPS, HEAD_DIM)
    kv = jnp.transpose(kv, (2, 0, 3, 1, 4))
    k_cmp = _rmsnorm(_compress(kv[0], cmp_pos[0], cmp_w1[0], cmp_b1[0], cmp_w2[0]), k_norm[0])
    v_cmp = _compress(kv[1], cmp_pos[1], cmp_w1[1], cmp_b1[1], cmp_w2[1])
    n_blk = s // SEL_BLOCK
    k_sel = _rmsnorm(kv[2], k_norm[1]).reshape(b, N_KV_GROUPS, n_blk, SEL_BLOCK, HEAD_DIM)
    v_sel = kv[3].reshape(b, N_KV_GROUPS, n_blk, SEL_BLOCK, HEAD_DIM)
    pad = ((0, 0), (0, 0), (WINDOW, 0), (0, 0))
    k_win = jnp.pad(_rmsnorm(kv[4], k_norm[2]), pad)
    v_win = jnp.pad(kv[5], pad)
    return (k_cmp, v_cmp, k_sel, v_sel, k_win, v_win)


def _softmax_f32(logits, mask):
    return jax.nn.softmax(jnp.where(mask, logits, MASK_SCORE), axis=-1)


def _nsa(x, w_qg, q_norm, w_o, k_cmp, v_cmp, k_sel, v_sel, k_win, v_win):
    b, s, _ = x.shape
    n_chunk = s // QUERY_CHUNK
    n_cmp = k_cmp.shape[2]
    n_blk = k_sel.shape[2]
    n_sel = min(N_SELECT, n_blk)
    scale = HEAD_DIM ** -0.5

    proj = x @ w_qg
    q = _rmsnorm(proj[..., :N_HEADS * HEAD_DIM].reshape(b, s, N_HEADS, HEAD_DIM), q_norm)
    gate = jax.nn.sigmoid(proj[..., N_HEADS * HEAD_DIM:].astype(jnp.float32))
    q = q.reshape(b, n_chunk, QUERY_CHUNK, N_KV_GROUPS, HEADS_PER_GROUP, HEAD_DIM)
    q = q.transpose(1, 0, 3, 4, 2, 5)
    gate = gate.reshape(b, n_chunk, QUERY_CHUNK, N_KV_GROUPS, HEADS_PER_GROUP, N_BRANCH)
    gate = gate.transpose(1, 0, 3, 4, 2, 5)

    cmp_start = np.arange(n_cmp) * CMP_STRIDE
    cmp_end = cmp_start + CMP_BLOCK - 1
    blk_start = np.arange(n_blk) * SEL_BLOCK
    overlap = ((cmp_start[:, None] < blk_start[None, :] + SEL_BLOCK)
               & (cmp_start[:, None] + CMP_BLOCK > blk_start[None, :])).astype(np.float32)
    gather_blocks = jax.vmap(jax.vmap(lambda kb, ib: kb[ib]))
    blk_ids = jnp.arange(n_blk)

    def chunk_fn(args):
        c, qc, gc = args
        t = c * QUERY_CHUNK + jnp.arange(QUERY_CHUNK)
        logits = jnp.einsum("bghtd,bgnd->bghtn", qc, k_cmp).astype(jnp.float32) * scale
        valid = cmp_end[None, :] <= t[:, None]
        p_cmp = _softmax_f32(logits, valid) * valid
        o_cmp = jnp.einsum("bghtn,bgnd->bghtd", p_cmp.astype(v_cmp.dtype), v_cmp)
        imp = jnp.einsum("bghtn,nj->bgtj", p_cmp, overlap)
        cur = (t // SEL_BLOCK)[:, None]
        forced = (blk_ids[None] == 0) | (blk_ids[None] == cur) | (blk_ids[None] == cur - 1)
        imp = jnp.where(forced, FORCE_SCORE, imp)
        imp = jnp.where(blk_ids[None] > cur, MASK_SCORE, imp)
        _, idx = lax.top_k(imp, n_sel)
        ks = gather_blocks(k_sel, idx).reshape(b, N_KV_GROUPS, QUERY_CHUNK, n_sel * SEL_BLOCK, HEAD_DIM)
        vs = gather_blocks(v_sel, idx).reshape(b, N_KV_GROUPS, QUERY_CHUNK, n_sel * SEL_BLOCK, HEAD_DIM)
        kpos = (idx[..., None] * SEL_BLOCK + jnp.arange(SEL_BLOCK)).reshape(
            b, N_KV_GROUPS, QUERY_CHUNK, n_sel * SEL_BLOCK)
        smask = (kpos <= t[:, None])[:, :, None]
        logits = jnp.einsum("bghtd,bgtkd->bghtk", qc, ks).astype(jnp.float32) * scale
        p_sel = _softmax_f32(logits, smask)
        o_sel = jnp.einsum("bghtk,bgtkd->bghtd", p_sel.astype(vs.dtype), vs)
        start = c * QUERY_CHUNK
        kw = lax.dynamic_slice_in_dim(k_win, start, WINDOW + QUERY_CHUNK, axis=2)
        vw = lax.dynamic_slice_in_dim(v_win, start, WINDOW + QUERY_CHUNK, axis=2)
        wpos = start - WINDOW + jnp.arange(WINDOW + QUERY_CHUNK)
        wmask = ((wpos[None] <= t[:, None]) & (wpos[None] > t[:, None] - WINDOW)
                 & (wpos[None] >= 0))
        logits = jnp.einsum("bghtd,bgkd->bghtk", qc, kw).astype(jnp.float32) * scale
        p_win = _softmax_f32(logits, wmask)
        o_win = jnp.einsum("bghtk,bgkd->bghtd", p_win.astype(vw.dtype), vw)
        out = gc[..., 0:1] * o_cmp + gc[..., 1:2] * o_sel + gc[..., 2:3] * o_win
        return out.astype(qc.dtype)

    outs = lax.map(chunk_fn, (jnp.arange(n_chunk), q, gate))
    o = outs.transpose(1, 0, 4, 2, 3, 5).reshape(b, s, N_HEADS * HEAD_DIM)
    return o @ w_o


def setup_inputs(seed: int = 0) -> dict:
    key = jax.random.key(seed)
    ks = jax.random.split(key, 20)
    nrm = lambda k, shape, scale: jax.random.normal(k, shape, jnp.float32) * scale
    gain = lambda k, shape: 1.0 + 0.02 * jax.random.normal(k, shape, jnp.float32)
    qg_width = N_HEADS * HEAD_DIM + N_BRANCH * N_HEADS
    return {
        "x": nrm(ks[0], (BATCH, SEQ, D_MODEL), 1.0),
        "ffn_norm": gain(ks[1], (DEPTH, 2, D_MODEL)),
        "ffn_w_gate_up": nrm(ks[2], (DEPTH, 2, D_MODEL, 2 * D_FF), D_MODEL ** -0.5),
        "ffn_w_down": nrm(ks[3], (DEPTH, 2, D_FF, D_MODEL), D_FF ** -0.5),
        "mix_norm": gain(ks[4], (DEPTH, D_MODEL)),
        "conv_w_in": nrm(ks[5], (N_A_LAYERS, D_MODEL, 3 * D_MODEL), D_MODEL ** -0.5),
        "conv_w": nrm(ks[6], (N_A_LAYERS, CONV_WIDTH, D_MODEL), CONV_WIDTH ** -0.5),
        "conv_w_out": nrm(ks[7], (N_A_LAYERS, D_MODEL, D_MODEL), D_MODEL ** -0.5),
        "kv_norm": gain(ks[8], (D_MODEL,)),
        "kv_w": nrm(ks[9], (D_MODEL, N_KV_SLOTS * N_KV_GROUPS * HEAD_DIM), D_MODEL ** -0.5),
        "cmp_pos": nrm(ks[10], (2, CMP_BLOCK, HEAD_DIM), 0.1),
        "cmp_w1": nrm(ks[11], (2, CMP_BLOCK * HEAD_DIM, CMP_HIDDEN), (CMP_BLOCK * HEAD_DIM) ** -0.5),
        "cmp_b1": nrm(ks[12], (2, CMP_HIDDEN), 0.01),
        "cmp_w2": nrm(ks[13], (2, CMP_HIDDEN, HEAD_DIM), CMP_HIDDEN ** -0.5),
        "k_norm": gain(ks[14], (N_BRANCH, HEAD_DIM)),
        "nsa_w_qg": nrm(ks[15], (N_B_LAYERS, D_MODEL, qg_width), D_MODEL ** -0.5),
        "q_norm": gain(ks[16], (N_B_LAYERS, HEAD_DIM)),
        "nsa_w_o": nrm(ks[17], (N_B_LAYERS, N_HEADS * HEAD_DIM, D_MODEL), (N_HEADS * HEAD_DIM) ** -0.5),
    }


def reference(x, ffn_norm, ffn_w_gate_up, ffn_w_down, mix_norm, conv_w_in, conv_w, conv_w_out,
              kv_norm, kv_w, cmp_pos, cmp_w1, cmp_b1, cmp_w2, k_norm, nsa_w_qg, q_norm, nsa_w_o):
    h = x
    shared = None
    for layer in range(DEPTH):
        h = h + 0.5 * _swiglu(_rmsnorm(h, ffn_norm[layer, 0]), ffn_w_gate_up[layer, 0], ffn_w_down[layer, 0])
        hn = _rmsnorm(h, mix_norm[layer])
        if layer < N_A_LAYERS:
            h = h + _short_conv(hn, conv_w_in[layer], conv_w[layer], conv_w_out[layer])
        else:
            i = layer - N_A_LAYERS
            h = h + _nsa(hn, nsa_w_qg[i], q_norm[i], nsa_w_o[i], *shared)
        h = h + 0.5 * _swiglu(_rmsnorm(h, ffn_norm[layer, 1]), ffn_w_gate_up[layer, 1], ffn_w_down[layer, 1])
        if layer == N_A_LAYERS - 1:
            shared = _shared_kv(h, kv_norm, kv_w, cmp_pos, cmp_w1, cmp_b1, cmp_w2, k_norm)
    return h
```

```cpp
#include <hip/hip_runtime.h>
#include <hip/hip_cooperative_groups.h>
#include <cstdio>
#include <cstdint>
namespace cg = cooperative_groups;

#define DI __device__ __forceinline__
#define LAS __attribute__((address_space(3)))
typedef unsigned short bf16_t;
typedef short bf16x8 __attribute__((ext_vector_type(8)));
typedef short s16x4 __attribute__((ext_vector_type(4)));
typedef float f32x2 __attribute__((ext_vector_type(2)));
typedef float f32x4 __attribute__((ext_vector_type(4)));
typedef float f32x16 __attribute__((ext_vector_type(16)));
typedef unsigned u32x2 __attribute__((ext_vector_type(2)));
typedef unsigned u32x4 __attribute__((ext_vector_type(4)));
typedef __bf16 bf16x2_t __attribute__((ext_vector_type(2)));
typedef short v4i16_t __attribute__((ext_vector_type(4)));

DI unsigned pk2(float lo, float hi) { f32x2 v = {lo, hi}; bf16x2_t b = __builtin_convertvector(v, bf16x2_t); return __builtin_bit_cast(unsigned, b); }
DI float bf2f(unsigned short u) { return __uint_as_float((unsigned)u << 16); }
DI float bflo(unsigned w) { return __uint_as_float(w << 16); }
DI float bfhi(unsigned w) { return __uint_as_float(w & 0xffff0000u); }

namespace pg8 {
#define PG8_LAS __attribute__((address_space(3)))
constexpr int BM = 256, BK = 64, HALF = 128, HTB = HALF * BK * 2, STAGE_BYTES = 8 * HTB, NXCD = 8, WGM = 8;
__host__ __device__ __forceinline__ int lds_byte(int r, int c) { const int st = (r >> 4) * 2 + (c >> 5), rr = r & 15, cc = c & 31, ob = rr * 64 + cc * 2; return st * 1024 + (ob ^ (((ob >> 9) & 1) << 5)); }
__host__ __device__ __forceinline__ void stage_rc(int b, int& R, int& C) { const int st = b / 1024, sb = b % 1024, swz = sb ^ (((sb >> 9) & 1) << 5); R = (st >> 1) * 16 + swz / 64; C = (st & 1) * 32 + (swz % 64) / 2; }
__host__ __device__ __forceinline__ int perm32(int rho) { const int n = rho >> 4, i = rho & 15; return 8 * (i >> 2) + 4 * n + (i & 3); }
struct Unit { int pm, pn; };
struct Gemm { const bf16_t* A; const bf16_t* Bt; int M, N, K, lda; };
struct StaticOrder {
    int nM, nN, nwg, G, c;
    __host__ __device__ void init(int M, int N, int G_, int c_) { nM = M / BM; nN = N / BM; nwg = nM * nN; G = G_; c = c_; }
    __host__ __device__ bool next(int i, Unit& u) const {
        const long L = (long)i * G + c; if (L >= nwg) return false;
        int wgid = (int)L; { const int q = nwg / NXCD, r = nwg % NXCD, xcd = wgid % NXCD, off = wgid / NXCD; wgid = (xcd < r ? xcd * (q + 1) : r * (q + 1) + (xcd - r) * q) + off; }
        const int nig = WGM * nN, gid = wgid / nig, fm = gid * WGM, gsz = (nM - fm) < WGM ? (nM - fm) : WGM;
        u.pm = fm + ((wgid % nig) % gsz); u.pn = (wgid % nig) / gsz; return true;
    }
    __device__ __forceinline__ void a_ready(const Unit&) const {}
    __device__ __forceinline__ void done(const Unit&) const {}
};
template <class Epi, class Sched, bool ALIGN_EPI = false, bool SP2 = false>
__device__ __forceinline__ void gemm_phase(PG8_LAS unsigned char* lds, const Gemm g, const Sched& S, const Epi& E) {
    const int tid = threadIdx.x, wid = __builtin_amdgcn_readfirstlane(tid >> 6), lane = tid & 63, wr = wid >> 2, wc = wid & 3, fr = lane & 15, fq = lane >> 4;
    const int K = g.K, nt = K / BK;
    unsigned voffA[2], voffB[2];
#pragma unroll
    for (int i = 0; i < 2; ++i) { int R, C; stage_rc(tid * 16 + i * 8192, R, C); const int Rb = Epi::PERM ? ((R & ~31) + perm32(R & 31)) : R;
        voffA[i] = (unsigned)(R * g.lda + C) * 2u; voffB[i] = (unsigned)(Rb * K + C) * 2u; }
    const size_t kstep = (size_t)(BK * 2);
    const size_t hstepA = (size_t)HALF * g.lda * 2, hstepB = (size_t)HALF * K * 2;
    const size_t tstepA = 2 * hstepA, tstepB = 2 * hstepB;
    const unsigned ldsw = (unsigned)wid * 1024u;
    const int aoff = lds_byte(wr * 64 + fr, fq * 8), boff = lds_byte(wc * 32 + fr, fq * 8);
#define PG8_SA(b, h) (((b) * 2 + (h)) * HTB)
#define PG8_SB(b, h) ((4 + (b) * 2 + (h)) * HTB)
#define PG8_STAGE(bufoff, gbase, voff) do { _Pragma("unroll") for (int _i = 0; _i < 2; ++_i) \
        __builtin_amdgcn_global_load_lds((const unsigned*)((const char*)(gbase) + (voff)[_i]), (PG8_LAS unsigned*)(lds + (bufoff) + ldsw + _i * 8192), 16, 0, 0); } while (0)
#define PG8_LDA(dst, b, h) do { _Pragma("unroll") for (int m = 0; m < 4; ++m) _Pragma("unroll") for (int k = 0; k < 2; ++k) dst[m][k] = *(const PG8_LAS bf16x8*)(lds + PG8_SA(b, h) + aoff + m * 2048 + k * 1024); } while (0)
#define PG8_LDB(dst, b, h) do { _Pragma("unroll") for (int n = 0; n < 2; ++n) _Pragma("unroll") for (int k = 0; k < 2; ++k) dst[n][k] = *(const PG8_LAS bf16x8*)(lds + PG8_SB(b, h) + boff + n * 2048 + k * 1024); } while (0)
#define PG8_MMA(ai, bj, At, Bt) do { __builtin_amdgcn_s_setprio(1); _Pragma("unroll") for (int m = 0; m < 4; ++m) _Pragma("unroll") for (int n = 0; n < 2; ++n) _Pragma("unroll") for (int k = 0; k < 2; ++k) \
        acc[ai][bj][m][n] = __builtin_amdgcn_mfma_f32_16x16x32_bf16(Bt[n][k], At[m][k], acc[ai][bj][m][n], 0, 0, 0); __builtin_amdgcn_s_setprio(0); } while (0)
#define PG8_WAIT_V(n) asm volatile("s_waitcnt vmcnt(" #n ")" ::: "memory")
#define PG8_WAIT_L(n) asm volatile("s_waitcnt lgkmcnt(" #n ")" ::: "memory")
#define PG8_BAR __builtin_amdgcn_s_barrier()
#define PG8_SCHED __builtin_amdgcn_sched_barrier(0)
    Unit cur, nxt; int ui = 0;
    if (!S.next(0, cur)) return;
    f32x4 acc[2][2][4][2];
#pragma unroll
    for (int a = 0; a < 2; ++a)
#pragma unroll
        for (int b = 0; b < 2; ++b)
#pragma unroll
            for (int m = 0; m < 4; ++m)
#pragma unroll
                for (int n = 0; n < 2; ++n) acc[a][b][m][n] = (f32x4){0.f, 0.f, 0.f, 0.f};
    bf16x8 At[4][2], B0[2][2], B1[2][2];
    const char* cA = (const char*)g.A + (size_t)cur.pm * tstepA; const char* cB = (const char*)g.Bt + (size_t)cur.pn * tstepB;
    S.a_ready(cur);
    if constexpr (SP2) {
        PG8_STAGE(PG8_SB(0, 0), cB, voffB); PG8_STAGE(PG8_SB(0, 1), cB + hstepB, voffB); PG8_STAGE(PG8_SA(0, 0), cA, voffA); PG8_STAGE(PG8_SA(0, 1), cA + hstepA, voffA);
        if (wr == 1) PG8_BAR;
        PG8_WAIT_V(2); PG8_BAR;
        PG8_STAGE(PG8_SB(1, 0), cB + kstep, voffB); PG8_STAGE(PG8_SA(1, 0), cA + kstep, voffA); PG8_STAGE(PG8_SB(1, 1), cB + hstepB + kstep, voffB);
        PG8_WAIT_V(6); PG8_BAR;
    } else {
        PG8_STAGE(PG8_SB(0, 0), cB, voffB); PG8_STAGE(PG8_SA(0, 0), cA, voffA); PG8_STAGE(PG8_SB(0, 1), cB + hstepB, voffB); PG8_STAGE(PG8_SA(0, 1), cA + hstepA, voffA);
        if (wr == 1) PG8_BAR;
        PG8_WAIT_V(4); PG8_BAR;
        PG8_STAGE(PG8_SB(1, 0), cB + kstep, voffB); PG8_STAGE(PG8_SA(1, 0), cA + kstep, voffA); PG8_STAGE(PG8_SB(1, 1), cB + hstepB + kstep, voffB);
        PG8_WAIT_V(6); PG8_BAR;
    }
    for (;;) {
        const bool has_next = S.next(ui + 1, nxt);
        const char* nA = has_next ? (const char*)g.A + (size_t)nxt.pm * tstepA : cA; const char* nB = has_next ? (const char*)g.Bt + (size_t)nxt.pn * tstepB : cB;
        for (int t = 0; t < nt; t += 2) {
            const bool last = (t == nt - 2);
            const char* a1 = cA + (size_t)(t + 1) * kstep;
            const char* a2 = last ? nA : cA + (size_t)(t + 2) * kstep; const char* b2 = last ? nB : cB + (size_t)(t + 2) * kstep;
            const char* a3 = a2 + kstep; const char* b3 = b2 + kstep;
            if (last && has_next) S.a_ready(nxt);
            if constexpr (SP2) {
            PG8_LDB(B0, 0, 0); PG8_LDB(B1, 0, 1); PG8_SCHED; PG8_LDA(At, 0, 0); PG8_STAGE(PG8_SA(1, 1), a1 + hstepA, voffA);
            PG8_WAIT_V(8); PG8_WAIT_L(0); PG8_BAR; PG8_MMA(0, 0, At, B0); PG8_MMA(0, 1, At, B1); PG8_BAR; PG8_SCHED;
            PG8_LDA(At, 0, 1); PG8_STAGE(PG8_SB(0, 0), b2, voffB); PG8_STAGE(PG8_SB(0, 1), b2 + hstepB, voffB); PG8_STAGE(PG8_SA(0, 0), a2, voffA);
            PG8_WAIT_V(8); PG8_WAIT_L(0); PG8_BAR; PG8_MMA(1, 0, At, B0); PG8_MMA(1, 1, At, B1); PG8_BAR; PG8_SCHED;
            PG8_LDB(B0, 1, 0); PG8_LDB(B1, 1, 1); PG8_SCHED; PG8_LDA(At, 1, 0); PG8_STAGE(PG8_SA(0, 1), a2 + hstepA, voffA);
            PG8_WAIT_V(8); PG8_WAIT_L(0); PG8_BAR; PG8_MMA(0, 0, At, B0); PG8_MMA(0, 1, At, B1); PG8_BAR; PG8_SCHED;
            PG8_LDA(At, 1, 1); PG8_STAGE(PG8_SB(1, 0), b3, voffB); PG8_STAGE(PG8_SB(1, 1), b3 + hstepB, voffB); PG8_STAGE(PG8_SA(1, 0), a3, voffA);
            PG8_WAIT_V(8); PG8_WAIT_L(0); PG8_BAR; PG8_MMA(1, 0, At, B0); PG8_MMA(1, 1, At, B1); PG8_BAR; PG8_SCHED;
            } else {
            PG8_LDB(B0, 0, 0); PG8_SCHED; PG8_LDA(At, 0, 0); PG8_STAGE(PG8_SA(1, 1), a1 + hstepA, voffA);
            PG8_WAIT_L(8); PG8_BAR; PG8_WAIT_L(0); PG8_MMA(0, 0, At, B0); PG8_BAR; PG8_SCHED;
            PG8_LDB(B1, 0, 1); PG8_STAGE(PG8_SB(0, 0), b2, voffB);
            PG8_BAR; PG8_WAIT_L(0); PG8_MMA(0, 1, At, B1); PG8_BAR;
            PG8_LDA(At, 0, 1); PG8_STAGE(PG8_SA(0, 0), a2, voffA);
            PG8_BAR; PG8_WAIT_L(0); PG8_MMA(1, 0, At, B0); PG8_BAR; PG8_SCHED;
            PG8_STAGE(PG8_SB(0, 1), b2 + hstepB, voffB);
            PG8_WAIT_V(6); PG8_BAR; PG8_MMA(1, 1, At, B1); PG8_BAR;
            PG8_LDB(B0, 1, 0); PG8_SCHED; PG8_LDA(At, 1, 0); PG8_STAGE(PG8_SA(0, 1), a2 + hstepA, voffA);
            PG8_WAIT_L(8); PG8_BAR; PG8_WAIT_L(0); PG8_MMA(0, 0, At, B0); PG8_BAR; PG8_SCHED;
            PG8_LDB(B1, 1, 1); PG8_STAGE(PG8_SB(1, 0), b3, voffB);
            PG8_BAR; PG8_WAIT_L(0); PG8_MMA(0, 1, At, B1); PG8_BAR;
            PG8_LDA(At, 1, 1); PG8_STAGE(PG8_SA(1, 0), a3, voffA);
            PG8_BAR; PG8_WAIT_L(0); PG8_MMA(1, 0, At, B0); PG8_BAR; PG8_SCHED;
            PG8_STAGE(PG8_SB(1, 1), b3 + hstepB, voffB);
            PG8_WAIT_V(6); PG8_BAR; PG8_MMA(1, 1, At, B1); PG8_BAR;
            }
        }
        if constexpr (ALIGN_EPI) { if (wr == 0) PG8_BAR; }
        if constexpr (!Epi::AFTER_DRAIN) { E(acc, cur, wr, wc, fr, fq); S.done(cur); }
        if (!has_next) break;
#pragma unroll
        for (int a = 0; a < 2; ++a)
#pragma unroll
            for (int b = 0; b < 2; ++b)
#pragma unroll
                for (int m = 0; m < 4; ++m)
#pragma unroll
                    for (int n = 0; n < 2; ++n) acc[a][b][m][n] = (f32x4){0.f, 0.f, 0.f, 0.f};
        cur = nxt; cA = nA; cB = nB; ++ui;
        if constexpr (ALIGN_EPI) { if (wr == 1) PG8_BAR; }
    }
    PG8_WAIT_V(0);
    if constexpr (!ALIGN_EPI) { if (wr == 0) PG8_BAR; }
    PG8_BAR;
    if constexpr (Epi::AFTER_DRAIN) { E.fused(acc, cur, wr, wc, fr, fq, lds, wid, lane); S.done(cur); }
#undef PG8_SA
#undef PG8_SB
#undef PG8_STAGE
#undef PG8_LDA
#undef PG8_LDB
#undef PG8_MMA
#undef PG8_WAIT_V
#undef PG8_WAIT_L
#undef PG8_BAR
#undef PG8_SCHED
}
}

constexpr int D = 1024, BATCH = 8, SEQ = 2048, M = BATCH * SEQ, DFF = 2816, NH = 16, HD = 64, NG = 4;
constexpr int NQG = 1072, NQGP = 1280, NKV = 1536, NGATE = 48;
constexpr float EPS = 1e-6f;
constexpr float QSCALE = 0.125f * 1.4426950408889634f;
constexpr float NEG = -1e30f;
constexpr size_t MiB = 1u << 20;
constexpr size_t WS_WGU = 1 * MiB, WS_WD = 45 * MiB, WS_WCIN = 67 * MiB, WS_WCOUT = 73 * MiB, WS_WKV = 75 * MiB, WS_WQG = 78 * MiB, WS_WO = 81 * MiB,
                 WS_WC1 = 83 * MiB, WS_WC2T = 85 * MiB, WS_BIASC = 85 * MiB + 256 * 1024, WS_SS = 86 * MiB, WS_HB = 87 * MiB, WS_H = 119 * MiB,
                 WS_ACT = 183 * MiB, WS_KV = 271 * MiB, WS_HID = 320 * MiB, WS_KCMP = 324 * MiB, WS_VCMP = 324 * MiB + 512 * 1024, WS_END = 325 * MiB;
constexpr size_t WS_VB = WS_ACT, WS_BG = WS_ACT + 32 * MiB, WS_Y = WS_KV;
constexpr size_t WS_QB = WS_ACT, WS_OB = WS_ACT + 32 * MiB, WS_GATE = WS_ACT + 64 * MiB;
constexpr size_t WGU_ELEMS = (size_t)2 * DFF * D, WD_ELEMS = (size_t)D * DFF, KVSLOT = (size_t)M * 256;
constexpr int LDS_BYTES = 147456;
constexpr int NPHASE = 16;

struct Args {
    const float *x, *ffn_norm, *w_gu, *w_down, *mix_norm, *conv_w_in, *conv_w, *conv_w_out, *kv_norm, *kv_w, *cmp_pos, *cmp_w1, *cmp_b1, *cmp_w2, *k_norm, *w_qg, *q_norm, *w_o;
    float* out; unsigned char* ws; int ph_lo, ph_hi;
};

DI float rstd_row(const float* SS, int row, int fq) {
    const f32x4 v = *(const f32x4*)(SS + (size_t)row * 16 + 4 * fq);
    float s = (v.x + v.y) + (v.z + v.w); s += __shfl_xor(s, 16); s += __shfl_xor(s, 32);
    return rsqrtf(s * (1.f / D) + EPS);
}
DI float sigm(float a) { return __builtin_amdgcn_rcpf(1.f + __expf(-a)); }
DI void rstd_rows(float (&rs)[2][4], const float* SS, int row0, int fq) {
    f32x4 v[2][4];
#pragma unroll
    for (int ai = 0; ai < 2; ++ai)
#pragma unroll
        for (int m = 0; m < 4; ++m) v[ai][m] = *(const f32x4*)(SS + (size_t)(row0 + ai * 128 + m * 16) * 16 + 4 * fq);
#pragma unroll
    for (int ai = 0; ai < 2; ++ai)
#pragma unroll
        for (int m = 0; m < 4; ++m) { float t = (v[ai][m].x + v[ai][m].y) + (v[ai][m].z + v[ai][m].w); t += __shfl_xor(t, 16); t += __shfl_xor(t, 32); rs[ai][m] = rsqrtf(t * (1.f / D) + EPS); }
}

struct EpiGU {
    static constexpr bool PERM = true, AFTER_DRAIN = false; const float* SS; bf16_t* ACT;
    DI void operator()(const f32x4 (&acc)[2][2][4][2], const pg8::Unit& u, int wr, int wc, int fr, int fq) const {
        const int row0 = u.pm * 256 + wr * 64 + fr; float rs[2][4]; rstd_rows(rs, SS, row0, fq);
        bf16_t* dst = ACT + (size_t)row0 * DFF + u.pn * 128 + wc * 32 + 8 * fq;
#pragma unroll
        for (int ai = 0; ai < 2; ++ai)
#pragma unroll
            for (int m = 0; m < 4; ++m) { const float r1 = rs[ai][m], r2 = r1 * r1, k1 = -1.4426950408889634f * r1; float o[8];
#pragma unroll
                for (int n = 0; n < 2; ++n)
#pragma unroll
                    for (int i = 0; i < 4; ++i) { const float ga = acc[ai][0][m][n][i], up = acc[ai][1][m][n][i];
                        o[4 * n + i] = (ga * up) * (r2 * __builtin_amdgcn_rcpf(1.f + __builtin_amdgcn_exp2f(ga * k1))); }
                u32x4 w; w.x = pk2(o[0], o[1]); w.y = pk2(o[2], o[3]); w.z = pk2(o[4], o[5]); w.w = pk2(o[6], o[7]);
                *(u32x4*)(dst + (size_t)(ai * 128 + m * 16) * DFF) = w; }
    }
};
template <bool SRC32, bool DST32> struct EpiRes {
    static constexpr bool PERM = true, AFTER_DRAIN = false; const float* src32; float* dst32; bf16_t* HB; float* SS; float scale;
    DI void operator()(const f32x4 (&acc)[2][2][4][2], const pg8::Unit& u, int wr, int wc, int fr, int fq) const {
#pragma unroll
        for (int ai = 0; ai < 2; ++ai) {
            const int row0 = u.pm * 256 + ai * 128 + wr * 64 + fr; const size_t off0 = (size_t)row0 * D + u.pn * 256 + wc * 32 + 8 * fq;
            f32x4 hv[4][2][2];
            if constexpr (SRC32) {
#pragma unroll
                for (int m = 0; m < 4; ++m)
#pragma unroll
                    for (int bj = 0; bj < 2; ++bj) { hv[m][bj][0] = *(const f32x4*)(src32 + off0 + (size_t)m * 16 * D + bj * 128); hv[m][bj][1] = *(const f32x4*)(src32 + off0 + (size_t)m * 16 * D + bj * 128 + 4); }
            } else {
                u32x4 hw[4][2];
#pragma unroll
                for (int m = 0; m < 4; ++m)
#pragma unroll
                    for (int bj = 0; bj < 2; ++bj) hw[m][bj] = *(const u32x4*)(HB + off0 + (size_t)m * 16 * D + bj * 128);
#pragma unroll
                for (int m = 0; m < 4; ++m)
#pragma unroll
                    for (int bj = 0; bj < 2; ++bj) { const u32x4 w = hw[m][bj]; hv[m][bj][0] = (f32x4){bflo(w.x), bfhi(w.x), bflo(w.y), bfhi(w.y)}; hv[m][bj][1] = (f32x4){bflo(w.z), bfhi(w.z), bflo(w.w), bfhi(w.w)}; }
            }
#pragma unroll
            for (int m = 0; m < 4; ++m) { float ssq = 0.f;
#pragma unroll
                for (int bj = 0; bj < 2; ++bj) { const size_t off = off0 + (size_t)m * 16 * D + bj * 128;
                    const f32x4 o0 = hv[m][bj][0] + acc[ai][bj][m][0] * scale, o1 = hv[m][bj][1] + acc[ai][bj][m][1] * scale;
                    if constexpr (DST32) { *(f32x4*)(dst32 + off) = o0; *(f32x4*)(dst32 + off + 4) = o1; }
                    else { ssq += (o0.x * o0.x + o0.y * o0.y) + (o0.z * o0.z + o0.w * o0.w) + (o1.x * o1.x + o1.y * o1.y) + (o1.z * o1.z + o1.w * o1.w);
                        u32x4 w; w.x = pk2(o0.x, o0.y); w.y = pk2(o0.z, o0.w); w.z = pk2(o1.x, o1.y); w.w = pk2(o1.z, o1.w); *(u32x4*)(HB + off) = w; } }
                if constexpr (!DST32) { ssq += __shfl_xor(ssq, 16); ssq += __shfl_xor(ssq, 32); if (fq == 0) SS[(size_t)(row0 + m * 16) * 16 + u.pn * 4 + wc] = ssq; } }
        }
    }
};
struct EpiConvIn {
    static constexpr bool PERM = true, AFTER_DRAIN = false; const float* SS; bf16_t* VB; bf16_t* BG;
    DI void operator()(const f32x4 (&acc)[2][2][4][2], const pg8::Unit& u, int wr, int wc, int fr, int fq) const {
        const int row0 = u.pm * 256 + wr * 64 + fr; float rs[2][4]; rstd_rows(rs, SS, row0, fq);
#pragma unroll
        for (int ai = 0; ai < 2; ++ai)
#pragma unroll
            for (int m = 0; m < 4; ++m) { const int row = row0 + ai * 128 + m * 16; const float r1 = rs[ai][m];
                if (u.pn < 8) { const float r2 = r1 * r1; const f32x4 v0 = acc[ai][0][m][0] * acc[ai][1][m][0] * r2, v1 = acc[ai][0][m][1] * acc[ai][1][m][1] * r2;
                    u32x4 w; w.x = pk2(v0.x, v0.y); w.y = pk2(v0.z, v0.w); w.z = pk2(v1.x, v1.y); w.w = pk2(v1.z, v1.w);
                    *(u32x4*)(VB + (size_t)row * D + u.pn * 128 + wc * 32 + 8 * fq) = w; }
                else {
#pragma unroll
                    for (int bj = 0; bj < 2; ++bj) { const f32x4 a = acc[ai][bj][m][0] * r1, b = acc[ai][bj][m][1] * r1;
                        u32x4 w; w.x = pk2(a.x, a.y); w.y = pk2(a.z, a.w); w.z = pk2(b.x, b.y); w.w = pk2(b.z, b.w);
                        *(u32x4*)(BG + (size_t)row * D + (u.pn - 8) * 256 + bj * 128 + wc * 32 + 8 * fq) = w; } } }
    }
};
struct EpiKV {
    static constexpr bool PERM = true, AFTER_DRAIN = false; const float* SS; bf16_t* KV; const float* knorm;
    DI void operator()(const f32x4 (&acc)[2][2][4][2], const pg8::Unit& u, int wr, int wc, int fr, int fq) const {
        const int slot = u.pn; const bool nrm = (slot == 2) || (slot == 4); const float* gn = knorm + (slot == 2 ? 64 : 128);
        f32x4 gv[2][2];
#pragma unroll
        for (int bj = 0; bj < 2; ++bj)
#pragma unroll
            for (int n = 0; n < 2; ++n) gv[bj][n] = nrm ? *(const f32x4*)(gn + bj * 32 + 8 * fq + 4 * n) : (f32x4){1.f, 1.f, 1.f, 1.f};
        float rsv[2][4]; rstd_rows(rsv, SS, u.pm * 256 + wr * 64 + fr, fq);
#pragma unroll
        for (int ai = 0; ai < 2; ++ai)
#pragma unroll
            for (int m = 0; m < 4; ++m) { const int row = u.pm * 256 + ai * 128 + wr * 64 + m * 16 + fr; const float rs = rsv[ai][m];
                f32x4 x[2][2]; float ss = 0.f;
#pragma unroll
                for (int bj = 0; bj < 2; ++bj)
#pragma unroll
                    for (int n = 0; n < 2; ++n) { x[bj][n] = acc[ai][bj][m][n] * rs; const f32x4 q = x[bj][n] * x[bj][n]; ss += (q.x + q.y) + (q.z + q.w); }
                ss += __shfl_xor(ss, 16); ss += __shfl_xor(ss, 32);
                const float rn = nrm ? rsqrtf(ss * (1.f / HD) + EPS) : 1.f;
                const int b = row >> 11, s = row & 2047;
                bf16_t* dst = KV + (size_t)slot * KVSLOT + ((size_t)(b * 4 + wc) * SEQ + s) * HD + 8 * fq;
#pragma unroll
                for (int bj = 0; bj < 2; ++bj) { const f32x4 y0 = x[bj][0] * gv[bj][0] * rn, y1 = x[bj][1] * gv[bj][1] * rn;
                    u32x4 w; w.x = pk2(y0.x, y0.y); w.y = pk2(y0.z, y0.w); w.z = pk2(y1.x, y1.y); w.w = pk2(y1.z, y1.w); *(u32x4*)(dst + bj * 32) = w; } }
    }
};
struct EpiQG {
    static constexpr bool PERM = true, AFTER_DRAIN = false; const float* SS; bf16_t* QB; float* GATE; const float* qnorm;
    DI void operator()(const f32x4 (&acc)[2][2][4][2], const pg8::Unit& u, int wr, int wc, int fr, int fq) const {
        f32x4 gv[2][2];
#pragma unroll
        for (int bj = 0; bj < 2; ++bj)
#pragma unroll
            for (int n = 0; n < 2; ++n) gv[bj][n] = *(const f32x4*)(qnorm + bj * 32 + 8 * fq + 4 * n);
        float rsv[2][4]; rstd_rows(rsv, SS, u.pm * 256 + wr * 64 + fr, fq);
#pragma unroll
        for (int ai = 0; ai < 2; ++ai)
#pragma unroll
            for (int m = 0; m < 4; ++m) { const int row = u.pm * 256 + ai * 128 + wr * 64 + m * 16 + fr; const float rs = rsv[ai][m];
                if (u.pn < 4) {
                    f32x4 x[2][2]; float ss = 0.f;
#pragma unroll
                    for (int bj = 0; bj < 2; ++bj)
#pragma unroll
                        for (int n = 0; n < 2; ++n) { x[bj][n] = acc[ai][bj][m][n] * rs; const f32x4 q = x[bj][n] * x[bj][n]; ss += (q.x + q.y) + (q.z + q.w); }
                    ss += __shfl_xor(ss, 16); ss += __shfl_xor(ss, 32);
                    const float rn = rsqrtf(ss * (1.f / HD) + EPS) * QSCALE;
                    bf16_t* dst = QB + (size_t)row * D + (u.pn * 4 + wc) * HD + 8 * fq;
#pragma unroll
                    for (int bj = 0; bj < 2; ++bj) { const f32x4 y0 = x[bj][0] * gv[bj][0] * rn, y1 = x[bj][1] * gv[bj][1] * rn;
                        u32x4 w; w.x = pk2(y0.x, y0.y); w.y = pk2(y0.z, y0.w); w.z = pk2(y1.x, y1.y); w.w = pk2(y1.z, y1.w); *(u32x4*)(dst + bj * 32) = w; }
                } else {
#pragma unroll
                    for (int n = 0; n < 2; ++n) { const int c = wc * 32 + 8 * fq + 4 * n;
                        if (c < NGATE) { const f32x4 v = acc[ai][0][m][n] * rs; f32x4 o; o.x = sigm(v.x); o.y = sigm(v.y); o.z = sigm(v.z); o.w = sigm(v.w);
                            *(f32x4*)(GATE + (size_t)row * NGATE + c) = o; } }
                } }
    }
};
struct EpiHid {
    static constexpr bool PERM = true, AFTER_DRAIN = false; const float* bias; bf16_t* HID;
    DI static float gelu(float x) { const float z2 = 1.5957691216f * (x + 0.044715f * x * x * x); return x * sigm(z2); }
    DI void operator()(const f32x4 (&acc)[2][2][4][2], const pg8::Unit& u, int wr, int wc, int fr, int fq) const {
#pragma unroll
        for (int ai = 0; ai < 2; ++ai)
#pragma unroll
            for (int m = 0; m < 4; ++m) { const int row = u.pm * 256 + ai * 128 + wr * 64 + m * 16 + fr;
#pragma unroll
                for (int bj = 0; bj < 2; ++bj) { const int col0 = bj * 128 + wc * 32 + 8 * fq;
                    const f32x4 v0 = acc[ai][bj][m][0] + *(const f32x4*)(bias + col0), v1 = acc[ai][bj][m][1] + *(const f32x4*)(bias + col0 + 4);
                    u32x4 w; w.x = pk2(gelu(v0.x), gelu(v0.y)); w.y = pk2(gelu(v0.z), gelu(v0.w)); w.z = pk2(gelu(v1.x), gelu(v1.y)); w.w = pk2(gelu(v1.z), gelu(v1.w));
                    *(u32x4*)(HID + (size_t)row * 256 + col0) = w; } }
    }
};

DI int colmap(int mapid, int p) {
    if (mapid == 1) { const int j = (p >> 8) * 128 + (p & 127); return ((p >> 7) & 1) ? DFF + j : j; }
    if (mapid == 2) { if (p < 2048) { const int j = (p >> 8) * 128 + (p & 127); return ((p >> 7) & 1) ? 2048 + j : 1024 + j; } return p - 2048; }
    if (mapid == 3 || (mapid == 4 && p < 1024)) { const int t = p >> 8, q = p & 255; return t * 256 + ((q >> 5) & 3) * 64 + (q >> 7) * 32 + (q & 31); }
    if (mapid == 4) return p < NQG ? p : -1;
    return p;
}
struct Job { const float* W; bf16_t* WT; const float* gain; int K, Nsrc, P, mapid; };
DI void transpose_item(const Job& j, int item, LAS float* scr, int lane) {
    const int nblk = j.P / 32, kb = item / nblk, nb = item % nblk, k0 = 64 * kb, p0 = 32 * nb;
    const int L = colmap(j.mapid, p0 + (lane & 31));
    float v[32];
#pragma unroll
    for (int i = 0; i < 32; ++i) { const int kk = 2 * i + (lane >> 5); v[i] = (L >= 0) ? j.W[(size_t)(k0 + kk) * j.Nsrc + L] : 0.f; }
    if (j.gain) {
#pragma unroll
        for (int i = 0; i < 32; ++i) v[i] *= j.gain[k0 + 2 * i + (lane >> 5)]; }
#pragma unroll
    for (int i = 0; i < 32; ++i) scr[(2 * i + (lane >> 5)) * 33 + (lane & 31)] = v[i];
    asm volatile("s_waitcnt lgkmcnt(0)" ::: "memory");
    const int c = lane & 7;
#pragma unroll
    for (int q = 0; q < 4; ++q) { const int n = (lane >> 3) + 8 * q; const LAS float* s = scr + (8 * c) * 33 + n;
        u32x4 o; o.x = pk2(s[0 * 33], s[1 * 33]); o.y = pk2(s[2 * 33], s[3 * 33]); o.z = pk2(s[4 * 33], s[5 * 33]); o.w = pk2(s[6 * 33], s[7 * 33]);
        *(u32x4*)(j.WT + (size_t)(p0 + n) * j.K + k0 + 8 * c) = o; }
    asm volatile("s_waitcnt lgkmcnt(0)" ::: "memory");
}
DI float wave_sum(float v) {
#pragma unroll
    for (int o = 1; o < 64; o <<= 1) v += __shfl_xor(v, o);
    return v;
}
namespace cv {
constexpr int I_GU = 16 * 176, I_D = 44 * 32, I_CIN = 16 * 96, I_SQ = 16 * 32, I_KV = 16 * 48, I_QG = 16 * 40, I_C1 = 32 * 8, I_C2 = 4 * 2;
constexpr int E0 = I_GU;
constexpr int E1 = E0 + I_D + I_CIN + I_SQ + I_GU;
constexpr int E2 = E1 + I_D + I_KV + I_GU + I_D + I_QG + 2 * I_C1 + 2 * I_C2;
constexpr int E3 = E2 + I_SQ + I_GU;
constexpr int E4 = E3 + I_D;
}
DI void convert_items(const Args& a, LAS unsigned char* lds, int first, int last, int worker, int nworkers) {
    using namespace cv;
    const int lane = threadIdx.x & 63, wave = __builtin_amdgcn_readfirstlane(threadIdx.x >> 6);
    LAS float* scr = (LAS float*)(lds + wave * 16384);
    unsigned char* ws = a.ws;
    for (int it = first + worker; it < last; it += nworkers) {
        int r = it; Job j;
#define GUJ(q) Job{a.w_gu + (size_t)(q) * WGU_ELEMS, (bf16_t*)(ws + WS_WGU) + (size_t)(q) * WGU_ELEMS, a.ffn_norm + (q) * D, D, 2 * DFF, 2 * DFF, 1}
#define DJ(q) Job{a.w_down + (size_t)(q) * WD_ELEMS, (bf16_t*)(ws + WS_WD) + (size_t)(q) * WD_ELEMS, nullptr, DFF, D, D, 0}
        if (r < I_GU) { j = GUJ(0); }
        else if ((r -= I_GU) < I_D) { j = DJ(0); }
        else if ((r -= I_D) < I_CIN) { j = Job{a.conv_w_in, (bf16_t*)(ws + WS_WCIN), a.mix_norm, D, 3 * D, 3 * D, 2}; }
        else if ((r -= I_CIN) < I_SQ) { j = Job{a.conv_w_out, (bf16_t*)(ws + WS_WCOUT), nullptr, D, D, D, 0}; }
        else if ((r -= I_SQ) < I_GU) { j = GUJ(1); }
        else if ((r -= I_GU) < I_D) { j = DJ(1); }
        else if ((r -= I_D) < I_KV) { j = Job{a.kv_w, (bf16_t*)(ws + WS_WKV), a.kv_norm, D, NKV, NKV, 3}; }
        else if ((r -= I_KV) < I_GU) { j = GUJ(2); }
        else if ((r -= I_GU) < I_D) { j = DJ(2); }
        else if ((r -= I_D) < I_QG) { j = Job{a.w_qg, (bf16_t*)(ws + WS_WQG), a.mix_norm + D, D, NQG, NQGP, 4}; }
        else if ((r -= I_QG) < 2 * I_C1) { const int q = r / I_C1; r -= q * I_C1; j = Job{a.cmp_w1 + (size_t)q * 2048 * 256, (bf16_t*)(ws + WS_WC1) + (size_t)q * 2048 * 256, nullptr, 2048, 256, 256, 0}; }
        else if ((r -= 2 * I_C1) < 2 * I_C2) { const int q = r / I_C2; r -= q * I_C2; j = Job{a.cmp_w2 + (size_t)q * 256 * 64, (bf16_t*)(ws + WS_WC2T) + (size_t)q * 256 * 64, nullptr, 256, 64, 64, 0}; }
        else if ((r -= 2 * I_C2) < I_SQ) { j = Job{a.w_o, (bf16_t*)(ws + WS_WO), nullptr, D, D, D, 0}; }
        else if ((r -= I_SQ) < I_GU) { j = GUJ(3); }
        else { r -= I_GU; j = DJ(3); }
#undef GUJ
#undef DJ
        transpose_item(j, r, scr, lane);
    }
}
DI void prologue(const Args& a, LAS unsigned char* lds) {
    const int tid = threadIdx.x, lane = tid & 63, wave = __builtin_amdgcn_readfirstlane(tid >> 6);
    const int gw = blockIdx.x * 8 + wave, NGW = gridDim.x * 8;
    unsigned char* ws = a.ws;
    convert_items(a, lds, 0, cv::E0, gw, NGW);
    bf16_t* HB = (bf16_t*)(ws + WS_HB); float* SS = (float*)(ws + WS_SS);
    for (int m0 = gw * 4; m0 < M; m0 += NGW * 4) {
        f32x4 v[4][4];
#pragma unroll
        for (int rr = 0; rr < 4; ++rr)
#pragma unroll
            for (int q = 0; q < 4; ++q) v[rr][q] = *((const f32x4*)(a.x + (size_t)(m0 + rr) * D) + lane + 64 * q);
#pragma unroll
        for (int rr = 0; rr < 4; ++rr) { float s = 0.f; unsigned long long* o8 = (unsigned long long*)(HB + (size_t)(m0 + rr) * D) + lane;
#pragma unroll
            for (int q = 0; q < 4; ++q) { const f32x4 w = v[rr][q]; s += (w.x * w.x + w.y * w.y) + (w.z * w.z + w.w * w.w);
                o8[64 * q] = (unsigned long long)pk2(w.x, w.y) | ((unsigned long long)pk2(w.z, w.w) << 32); }
            s = wave_sum(s);
            if (lane < 16) SS[(size_t)(m0 + rr) * 16 + lane] = (lane == 0) ? s : 0.f; }
    }
    for (int c = gw; c < 512; c += NGW) { const int slot = c >> 8, col = c & 255; float s = 0.f;
        const float* pos = a.cmp_pos + slot * 2048; const float* w1 = a.cmp_w1 + (size_t)slot * 2048 * 256 + col;
        for (int k = lane; k < 2048; k += 64) s += pos[k] * w1[(size_t)k * 256];
        s = wave_sum(s);
        if (lane == 0) ((float*)(ws + WS_BIASC))[c] = s + a.cmp_b1[c]; }
}

DI void conv_phase(const Args& a) {
    const bf16_t* VB = (const bf16_t*)(a.ws + WS_VB); const bf16_t* BG = (const bf16_t*)(a.ws + WS_BG); bf16_t* Y = (bf16_t*)(a.ws + WS_Y);
    const bool byx = (gridDim.x % 8 == 0);
    const int ibase = byx ? (int)(blockIdx.x % 8) * (M / 8) * 128 : 0, iend = byx ? ibase + (M / 8) * 128 : M * 128;
    const int nth = byx ? (int)(gridDim.x / 8) * 512 : (int)gridDim.x * 512, ifirst = ibase + (byx ? (int)(blockIdx.x / 8) : (int)blockIdx.x) * 512 + (int)threadIdx.x;
    for (int idx = ifirst; idx < iend; idx += nth) {
        const int m = idx >> 7, k0 = (idx & 127) * 8, s = m & (SEQ - 1); const size_t off = (size_t)m * D + k0;
        const u32x4 z = {0u, 0u, 0u, 0u};
        const u32x4 v0 = *(const u32x4*)(VB + off), v1 = s >= 1 ? *(const u32x4*)(VB + off - D) : z, v2 = s >= 2 ? *(const u32x4*)(VB + off - 2 * D) : z, bg = *(const u32x4*)(BG + off);
        const f32x4 c0a = *(const f32x4*)(a.conv_w + k0), c0b = *(const f32x4*)(a.conv_w + k0 + 4), c1a = *(const f32x4*)(a.conv_w + D + k0), c1b = *(const f32x4*)(a.conv_w + D + k0 + 4),
                    c2a = *(const f32x4*)(a.conv_w + 2 * D + k0), c2b = *(const f32x4*)(a.conv_w + 2 * D + k0 + 4);
        float w0[8] = {c0a.x, c0a.y, c0a.z, c0a.w, c0b.x, c0b.y, c0b.z, c0b.w}, w1[8] = {c1a.x, c1a.y, c1a.z, c1a.w, c1b.x, c1b.y, c1b.z, c1b.w}, w2[8] = {c2a.x, c2a.y, c2a.z, c2a.w, c2b.x, c2b.y, c2b.z, c2b.w};
        u32x4 o;
#pragma unroll
        for (int q = 0; q < 4; ++q) {
            const float lo = bflo(bg[q]) * (w0[2 * q] * bflo(v2[q]) + w1[2 * q] * bflo(v1[q]) + w2[2 * q] * bflo(v0[q]));
            const float hi = bfhi(bg[q]) * (w0[2 * q + 1] * bfhi(v2[q]) + w1[2 * q + 1] * bfhi(v1[q]) + w2[2 * q + 1] * bfhi(v0[q]));
            o[q] = pk2(lo, hi); }
        *(u32x4*)(Y + off) = o;
    }
}

DI int crow(int reg, int h) { return (reg & 3) + 8 * (reg >> 2) + 4 * h; }
#define MFMA32(a, b, c) __builtin_amdgcn_mfma_f32_32x32x16_bf16((a), (b), (c), 0, 0, 0)
DI void cmp2_unit(const Args& a, int slot, int rg) {
    const int tid = threadIdx.x, lane = tid & 63, r = lane & 31, h = lane >> 5;
    {
        const bf16_t* HID = (const bf16_t*)(a.ws + WS_HID) + (size_t)slot * 4096 * 256 + (size_t)(32 * rg + r) * 256 + 8 * h;
        const bf16_t* W2T = (const bf16_t*)(a.ws + WS_WC2T) + (size_t)slot * 64 * 256 + (size_t)r * 256 + 8 * h;
        f32x16 o[2]; o[0] = f32x16{}; o[1] = f32x16{};
#pragma unroll 4
        for (int kk = 0; kk < 16; ++kk) { const bf16x8 hb = *(const bf16x8*)(HID + 16 * kk);
            const bf16x8 w0 = *(const bf16x8*)(W2T + 16 * kk), w1 = *(const bf16x8*)(W2T + 32 * 256 + 16 * kk);
            o[0] = MFMA32(w0, hb, o[0]); o[1] = MFMA32(w1, hb, o[1]); }
        float rn = 1.f;
        if (slot == 0) { float ss = 0.f;
#pragma unroll
            for (int dt = 0; dt < 2; ++dt)
#pragma unroll
                for (int q = 0; q < 16; ++q) ss += o[dt][q] * o[dt][q];
            ss += __shfl_xor(ss, 32); rn = rsqrtf(ss * (1.f / HD) + EPS); }
        bf16_t* dst = (bf16_t*)(a.ws + (slot == 0 ? WS_KCMP : WS_VCMP)) + (size_t)(32 * rg + r) * 64;
#pragma unroll
        for (int dt = 0; dt < 2; ++dt)
#pragma unroll
            for (int gq = 0; gq < 4; ++gq) { const int d = 32 * dt + 8 * gq + 4 * h; f32x4 g = {1.f, 1.f, 1.f, 1.f}; if (slot == 0) g = *(const f32x4*)(a.k_norm + d);
                u32x2 w; w.x = pk2(o[dt][4 * gq] * rn * g.x, o[dt][4 * gq + 1] * rn * g.y); w.y = pk2(o[dt][4 * gq + 2] * rn * g.z, o[dt][4 * gq + 3] * rn * g.w);
                *(u32x2*)(dst + d) = w; }
    }
}

namespace nsa {
constexpr int ROWB = 144;
constexpr int TILEB = 64 * ROWB;
constexpr int L_KV = 0;
constexpr int L_S4 = 36864;
constexpr int L_LS = L_S4 + 4 * 64 * 33 * 4;
constexpr int L_IMP = L_LS + 4 * 64 * 33 * 4;
constexpr int L_SELM = L_IMP + 64 * 33 * 4;
constexpr int L_END = L_SELM + 65 * 4;
static_assert(L_END <= 131072, "nsa LDS map");
DI s16x4 vtr(LAS const char* p) { return __builtin_bit_cast(s16x4, __builtin_amdgcn_ds_read_tr16_b64_v4i16((LAS v4i16_t*)p)); }
DI void qk_tile(f32x16& st, LAS const char* kb, const bf16x8 (&qf)[4]) {
    st = f32x16{};
#pragma unroll
    for (int kk = 0; kk < 4; ++kk) { const bf16x8 kf = *(LAS const bf16x8*)(kb + kk * 32); st = MFMA32(kf, qf[kk], st); }
}
DI void pv_tile(f32x16 (&o)[2], const f32x16& p, LAS const char* vb) {
#pragma unroll
    for (int s = 0; s < 2; ++s) {
        u32x4 w; w.x = pk2(p[8 * s], p[8 * s + 1]); w.y = pk2(p[8 * s + 2], p[8 * s + 3]); w.z = pk2(p[8 * s + 4], p[8 * s + 5]); w.w = pk2(p[8 * s + 6], p[8 * s + 7]);
        const bf16x8 pb = __builtin_bit_cast(bf16x8, w);
#pragma unroll
        for (int dt = 0; dt < 2; ++dt) { const s16x4 lo = vtr(vb + (16 * s) * ROWB + dt * 64), hi = vtr(vb + (16 * s + 8) * ROWB + dt * 64);
            const bf16x8 va = __builtin_shufflevector(lo, hi, 0, 1, 2, 3, 4, 5, 6, 7);
            o[dt] = MFMA32(va, pb, o[dt]); }
    }
}
DI void nsa_step(LAS char* lds, int i, int j_cur, int n_sel, int tb, int th, unsigned selm, int tlh, float g1, int koff, int voff, const bf16x8 (&qf)[4],
                 f32x16 (&acc)[2], f32x16 (&tot)[2], float& l_run) {
    if (i == n_sel) {
        const float lt = l_run + __shfl_xor(l_run, 32); const float sc = g1 / lt;
        tot[0] += acc[0] * sc; tot[1] += acc[1] * sc; acc[0] = f32x16{}; acc[1] = f32x16{}; l_run = 0.f; }
    const bool is_win = (i >= n_sel);
    const bool lane_ok = is_win ? true : (((selm >> j_cur) & 1u) != 0u);
    if (__any(lane_ok)) {
        LAS const char* kbuf = lds + L_KV + (i & 1) * 2 * TILEB; LAS const char* vbuf = kbuf + TILEB;
        bf16x8 kf[2][4]; s16x4 vlo[2][2][2], vhi[2][2][2];
#pragma unroll
        for (int c = 0; c < 2; ++c)
#pragma unroll
            for (int kk = 0; kk < 4; ++kk) kf[c][kk] = *(LAS const bf16x8*)(kbuf + (32 * c) * ROWB + koff + kk * 32);
        __builtin_amdgcn_sched_barrier(0);
        f32x16 st[2]; st[0] = f32x16{}; st[1] = f32x16{};
#pragma unroll
        for (int kk = 0; kk < 4; ++kk) { st[0] = MFMA32(kf[0][kk], qf[kk], st[0]); st[1] = MFMA32(kf[1][kk], qf[kk], st[1]); }
        __builtin_amdgcn_sched_barrier(0);
#pragma unroll
        for (int c = 0; c < 2; ++c)
#pragma unroll
            for (int sx = 0; sx < 2; ++sx)
#pragma unroll
                for (int dt = 0; dt < 2; ++dt) { vlo[c][sx][dt] = vtr(vbuf + voff + (32 * c + 16 * sx) * ROWB + dt * 64); vhi[c][sx][dt] = vtr(vbuf + voff + (32 * c + 16 * sx + 8) * ROWB + dt * 64); }
        __builtin_amdgcn_sched_barrier(0);
        const bool causal = (j_cur == tb), lower = is_win && (j_cur == tb - 8);
        if (causal || lower || !__all(lane_ok)) {
#pragma unroll
            for (int c = 0; c < 2; ++c)
#pragma unroll
                for (int q = 0; q < 16; ++q) { const int kl = 32 * c + crow(q, 0);
                    const bool masked = (!lane_ok) || (causal && kl > tlh) || (lower && kl <= tlh);
                    if (masked) st[c][q] = NEG; }
        }
        const bool dead0 = lower && th == 1, dead1 = causal && th == 0;
        float ls0 = 0.f, ls1 = 0.f;
        if (!dead0) {
#pragma unroll
            for (int q = 0; q < 16; ++q) { const float p0 = __builtin_amdgcn_exp2f(st[0][q]); st[0][q] = p0; ls0 += p0; } }
        if (!dead1) {
#pragma unroll
            for (int q = 0; q < 16; ++q) { const float p1 = __builtin_amdgcn_exp2f(st[1][q]); st[1][q] = p1; ls1 += p1; } }
        l_run += ls0 + ls1;
#pragma unroll
        for (int c = 0; c < 2; ++c) if (!(c == 0 ? dead0 : dead1))
#pragma unroll
            for (int sx = 0; sx < 2; ++sx) {
                u32x4 w; w.x = pk2(st[c][8 * sx], st[c][8 * sx + 1]); w.y = pk2(st[c][8 * sx + 2], st[c][8 * sx + 3]); w.z = pk2(st[c][8 * sx + 4], st[c][8 * sx + 5]); w.w = pk2(st[c][8 * sx + 6], st[c][8 * sx + 7]);
                const bf16x8 pb = __builtin_bit_cast(bf16x8, w);
#pragma unroll
                for (int dt = 0; dt < 2; ++dt) { const bf16x8 va = __builtin_shufflevector(vlo[c][sx][dt], vhi[c][sx][dt], 0, 1, 2, 3, 4, 5, 6, 7); acc[dt] = MFMA32(va, pb, acc[dt]); } }
    }
}
DI void nsa_unit(LAS char* lds, int b, int g, int tb, const bf16_t* QB, const float* GATE, const bf16_t* KV, const bf16_t* KCMP, const bf16_t* VCMP, bf16_t* OB) {
    const int tid = threadIdx.x, lane = tid & 63, wave = __builtin_amdgcn_readfirstlane(tid >> 6), r = lane & 31, h = lane >> 5;
    const int hh = wave & 3, th = wave >> 2, head = g * 4 + hh, bg = b * 4 + g;
    const int t0 = tb * 64, tl = th * 32 + r, t = t0 + tl; const size_t m = (size_t)b * SEQ + t;
    bf16x8 qf[4];
#pragma unroll
    for (int kk = 0; kk < 4; ++kk) qf[kk] = *(const bf16x8*)(QB + m * D + head * HD + kk * 16 + h * 8);
    const float g0 = GATE[m * NGATE + head * 3 + 0], g1 = GATE[m * NGATE + head * 3 + 1], g2 = GATE[m * NGATE + head * 3 + 2];
    const bf16_t* Ksel = KV + 2 * KVSLOT + (size_t)bg * SEQ * HD + tid * 8; const bf16_t* Kwin = KV + 4 * KVSLOT + (size_t)bg * SEQ * HD + tid * 8;
    u32x4 kA = *(const u32x4*)Ksel, vA = *(const u32x4*)(Ksel + KVSLOT);
    LAS unsigned* SELM = (LAS unsigned*)(lds + L_SELM);
    if (tid < 65) SELM[tid] = 0u;
#pragma unroll
    for (int i = 0; i < 2; ++i) { const int c = tid + 512 * i, row = c >> 3, ch = c & 7;
        *(LAS u32x4*)(lds + L_KV + row * ROWB + ch * 16) = *(const u32x4*)(KCMP + (size_t)bg * 8192 + c * 8);
        *(LAS u32x4*)(lds + L_KV + (128 + row) * ROWB + ch * 16) = *(const u32x4*)(VCMP + (size_t)bg * 8192 + c * 8); }
    __syncthreads();
    const int i16 = lane & 15, q4 = i16 >> 2, p4 = i16 & 3, blk = (lane >> 4) & 1;
    const int koff = r * ROWB + h * 16, voff = (4 * h + q4) * ROWB + blk * 32 + p4 * 8;
    f32x16 tot[2];
    {
        f32x16 st[4];
        const int tmaxw = t0 + 32 * th + 31, nmaxw = (tmaxw - 31) >> 4;
#pragma unroll
        for (int c = 0; c < 4; ++c) { if (32 * c <= nmaxw) qk_tile(st[c], lds + L_KV + (32 * c) * ROWB + koff, qf); else st[c] = f32x16{}; }
        const int nmax = ((t >= 31) ? ((t - 31) >> 4) : -1) - 4 * h;
        float mx = NEG;
#pragma unroll
        for (int c = 0; c < 4; ++c)
#pragma unroll
            for (int q = 0; q < 16; ++q) { const int n = 32 * c + crow(q, 0); if (n > nmax) st[c][q] = NEG; mx = fmaxf(mx, st[c][q]); }
        mx = fmaxf(mx, __shfl_xor(mx, 32));
        float sum = 0.f;
#pragma unroll
        for (int c = 0; c < 4; ++c)
#pragma unroll
            for (int q = 0; q < 16; ++q) { const int n = 32 * c + crow(q, 0); const float p = (n <= nmax && 32 * c <= nmaxw) ? __builtin_amdgcn_exp2f(st[c][q] - mx) : 0.f; st[c][q] = p; sum += p; }
        sum += __shfl_xor(sum, 32);
        const float inv = sum > 0.f ? 1.f / sum : 0.f;
#pragma unroll
        for (int c = 0; c < 4; ++c) st[c] = st[c] * inv;
        if (tb > 15) {
            LAS float* S4 = (LAS float*)(lds + L_S4) + (hh * 64 + tl) * 33; LAS float* LS = (LAS float*)(lds + L_LS) + (hh * 64 + tl) * 33;
#pragma unroll
            for (int c = 0; c < 4; ++c)
#pragma unroll
                for (int gq = 0; gq < 4; ++gq) { const int ch = 8 * c + 2 * gq + h;
                    S4[ch] = (st[c][4 * gq] + st[c][4 * gq + 1]) + (st[c][4 * gq + 2] + st[c][4 * gq + 3]);
                    if (ch < 31) LS[ch + 1] = st[c][4 * gq + 3]; else LS[0] = 0.f; }
        }
        f32x16 o[2]; o[0] = f32x16{}; o[1] = f32x16{};
#pragma unroll
        for (int c = 0; c < 4; ++c) if (32 * c <= nmaxw) pv_tile(o, st[c], lds + L_KV + (128 + 32 * c) * ROWB + voff);
        tot[0] = o[0] * g0; tot[1] = o[1] * g0;
    }
    __syncthreads();
    if (tb > 15) {
        const int tt = tid >> 3, jj = tid & 7;
        LAS const float* S4 = (LAS const float*)(lds + L_S4); LAS const float* LS = (LAS const float*)(lds + L_LS); LAS float* IMP = (LAS float*)(lds + L_IMP);
#pragma unroll
        for (int i = 0; i < 4; ++i) { const int j = jj + 8 * i; float v = 0.f;
#pragma unroll
            for (int q = 0; q < 4; ++q) v += S4[(q * 64 + tt) * 33 + j] + LS[(q * 64 + tt) * 33 + j];
            if (j == 0 || j == tb || j == tb - 1) v = 1e9f;
            if (j > tb) v = NEG;
            IMP[tt * 33 + j] = v; }
        __syncthreads();
        unsigned bits = 0u;
        float vv[4]; int rank[4];
#pragma unroll
        for (int i = 0; i < 4; ++i) { vv[i] = IMP[tt * 33 + jj + 8 * i]; rank[i] = 0; }
#pragma unroll 1
        for (int j2 = 0; j2 <= tb; ++j2) { const float v2 = IMP[tt * 33 + j2];
#pragma unroll
            for (int i = 0; i < 4; ++i) rank[i] += (v2 > vv[i] || (v2 == vv[i] && j2 < jj + 8 * i)) ? 1 : 0; }
#pragma unroll
        for (int i = 0; i < 4; ++i) { const int j = jj + 8 * i; if (rank[i] < 16 && j <= tb) bits |= 1u << j; }
        if (bits) { atomicOr((unsigned*)&SELM[tt], bits); atomicOr((unsigned*)&SELM[64], bits); }
        __syncthreads();
    }
    const unsigned allm = (2u << tb) - 1u;
    const unsigned selm = tb > 15 ? SELM[tl] : allm, umask = tb > 15 ? SELM[64] : allm;
    const int n_sel = __builtin_popcount(umask), jw0 = tb > 8 ? tb - 8 : 0, n_steps = n_sel + (tb - jw0 + 1);
    unsigned pf_rem = umask & ~1u; int pf_i = 1, jA = 0, jB = 0, j_cur;
    u32x4 kB, vB;
#define NSA_LOAD(KR, VR, JR) do { const bf16_t* kp_; if (pf_i < n_sel) { JR = __builtin_ctz(pf_rem); pf_rem &= pf_rem - 1u; kp_ = Ksel; } else { JR = jw0 + (pf_i - n_sel); JR = JR > tb ? tb : JR; kp_ = Kwin; } ++pf_i; \
        KR = *(const u32x4*)(kp_ + (size_t)JR * 64 * HD); VR = *(const u32x4*)(kp_ + KVSLOT + (size_t)JR * 64 * HD); } while (0)
#define NSA_STORE(buf, KR, VR) do { LAS char* d_ = lds + L_KV + (buf) * 2 * TILEB + (tid >> 3) * ROWB + (tid & 7) * 16; *(LAS u32x4*)d_ = KR; *(LAS u32x4*)(d_ + TILEB) = VR; } while (0)
    j_cur = 0; NSA_STORE(0, kA, vA);
    NSA_LOAD(kA, vA, jA);
    __syncthreads();
    const int tlh = tl - 4 * h;
    float l_run = 0.f; f32x16 acc[2]; acc[0] = f32x16{}; acc[1] = f32x16{};
    for (int i = 0; i < n_steps; i += 2) {
        NSA_LOAD(kB, vB, jB);
        nsa_step(lds, i, j_cur, n_sel, tb, th, selm, tlh, g1, koff, voff, qf, acc, tot, l_run);
        if (i + 1 < n_steps) NSA_STORE((i + 1) & 1, kA, vA);
        j_cur = jA;
        __syncthreads();
        if (i + 1 >= n_steps) break;
        NSA_LOAD(kA, vA, jA);
        nsa_step(lds, i + 1, j_cur, n_sel, tb, th, selm, tlh, g1, koff, voff, qf, acc, tot, l_run);
        if (i + 2 < n_steps) NSA_STORE((i + 2) & 1, kB, vB);
        j_cur = jB;
        __syncthreads();
    }
    {   const float lt = l_run + __shfl_xor(l_run, 32); const float sc = g2 / lt; tot[0] += acc[0] * sc; tot[1] += acc[1] * sc; }
    bf16_t* dst = OB + m * D + head * HD + 4 * h;
#pragma unroll
    for (int dt = 0; dt < 2; ++dt)
#pragma unroll
        for (int gq = 0; gq < 4; ++gq) { u32x2 w; w.x = pk2(tot[dt][4 * gq], tot[dt][4 * gq + 1]); w.y = pk2(tot[dt][4 * gq + 2], tot[dt][4 * gq + 3]);
            *(u32x2*)(dst + 32 * dt + 8 * gq) = w; }
#undef NSA_LOAD
#undef NSA_STORE
}
DI void nsa_phase(const Args& a, LAS char* lds) {
    const bf16_t* QB = (const bf16_t*)(a.ws + WS_QB); const float* GATE = (const float*)(a.ws + WS_GATE); const bf16_t* KV = (const bf16_t*)(a.ws + WS_KV);
    const bf16_t* KCMP = (const bf16_t*)(a.ws + WS_KCMP); const bf16_t* VCMP = (const bf16_t*)(a.ws + WS_VCMP); bf16_t* OB = (bf16_t*)(a.ws + WS_OB);
    const int Gn = gridDim.x, vcu = (Gn % 8 == 0) ? (blockIdx.x % 8) * (Gn / 8) + blockIdx.x / 8 : blockIdx.x;
    for (int u = vcu; u < 1024; u += Gn) {
        const int c = u & 255, rnd = u >> 8, bgi = c >> 3, s = c & 7;
        const int tb = rnd == 0 ? s : rnd == 1 ? 15 - s : rnd == 2 ? 16 + s : 31 - s;
        nsa_unit(lds, bgi >> 2, bgi & 3, tb, QB, GATE, KV, KCMP, VCMP, OB);
    }
}
}

#define XB_TMO      128
#define XB_XCNT(j)  (256  + 64 * (j))
#define XB_XSUB(j)  (1280 + 64 * (j))
#define XB_XGEN(j)  (2304 + 64 * (j))
#define XB_TOP      3328
#define XB_TOPGEN   3392
#define XCD_BAR_WORDS 3456
#define XB_SPIN_CAP (1u << 18)

__device__ __forceinline__ unsigned xb_ld(unsigned* p)              { return __hip_atomic_load(p, __ATOMIC_RELAXED, __HIP_MEMORY_SCOPE_AGENT); }
__device__ __forceinline__ unsigned xb_add(unsigned* p, unsigned v) { return __hip_atomic_fetch_add(p, v, __ATOMIC_RELAXED, __HIP_MEMORY_SCOPE_AGENT); }
__device__ __forceinline__ unsigned xb_xcc_id() { return (unsigned)__builtin_amdgcn_s_getreg((3 << 11) | 20) & 0xFu; }
#define XB_SPIN(cond, bar) do { unsigned _sp = 0; while (cond) { __builtin_amdgcn_s_sleep(1); \
    if ((++_sp & 255u) == 0u) { if (xb_ld(&(bar)[XB_TMO])) break; if (_sp > XB_SPIN_CAP) { atomicAdd(&(bar)[XB_TMO], 1u); break; } } } } while (0)

struct XcdBarrier {
    unsigned* bar; unsigned x;
    volatile LAS unsigned* st;
};

__device__ __forceinline__ XcdBarrier xcd_barrier_post(unsigned* bar, volatile LAS unsigned* st) {
    XcdBarrier b; b.bar = bar; b.x = xb_xcc_id(); b.st = st;
    if (threadIdx.x == 0) (void)xb_add(&bar[XB_XCNT(b.x)], 1u);
    return b;
}
__device__ __forceinline__ void xcd_barrier_complete(unsigned* bar, unsigned x, unsigned& nloc, unsigned& nx) {
    const unsigned G = gridDim.x * gridDim.y * gridDim.z;
    unsigned sum, cnt, mine, sp = 0u;
    for (;;) {
        sum = 0u; cnt = 0u; mine = 0u;
#pragma unroll
        for (unsigned j = 0; j < 16; ++j) { const unsigned c = xb_ld(&bar[XB_XCNT(j)]); sum += c; cnt += (c > 0u) ? 1u : 0u; mine = (j == x) ? c : mine; }
        if (sum == G) break;
        __builtin_amdgcn_s_sleep(1);
        if ((++sp & 255u) == 0u) { if (xb_ld(&bar[XB_TMO])) break; if (sp > XB_SPIN_CAP) { atomicAdd(&bar[XB_TMO], 1u); break; } }
    }
    nloc = mine > 0u ? mine : 1u; nx = cnt > 0u ? cnt : 1u;
}

__device__ __forceinline__ void xcd_barrier(const XcdBarrier& b) {
    asm volatile("s_waitcnt vmcnt(0)" ::: "memory");
    __syncthreads();
    if (threadIdx.x == 0) {
        unsigned* bar = b.bar;
        __builtin_amdgcn_s_waitcnt(0);
        unsigned nloc = b.st[0], nx = b.st[1];
        if (nloc == 0u) { xcd_barrier_complete(bar, b.x, nloc, nx); b.st[0] = nloc; b.st[1] = nx; }
        const unsigned old = xb_add(&bar[XB_XSUB(b.x)], 1u);
        const unsigned gen = old / nloc;
        if (old + 1u == (gen + 1u) * nloc) {
            __builtin_amdgcn_fence(__ATOMIC_RELEASE, "agent");
            asm volatile("s_waitcnt vmcnt(0)" ::: "memory");
            const unsigned og = xb_add(&bar[XB_TOP], 1u);
            const unsigned tg = og / nx;
            if (og + 1u == (tg + 1u) * nx) xb_add(&bar[XB_TOPGEN], 1u);
            else XB_SPIN(xb_ld(&bar[XB_TOPGEN]) == tg, bar);
            __builtin_amdgcn_fence(__ATOMIC_ACQUIRE, "agent");
            xb_add(&bar[XB_XGEN(b.x)], 1u);
            asm volatile("s_waitcnt vmcnt(0)" ::: "memory");
        } else {
            XB_SPIN(xb_ld(&bar[XB_XGEN(b.x)]) == gen, bar);
            __builtin_amdgcn_fence(__ATOMIC_ACQUIRE, "agent");
            asm volatile("s_waitcnt vmcnt(0)" ::: "memory");
        }
    }
    __syncthreads();
}


__device__ __forceinline__ void xcc_barrier_light(const XcdBarrier& b) {
    asm volatile("s_waitcnt vmcnt(0)" ::: "memory");
    __syncthreads();
    if (threadIdx.x == 0) {
        unsigned* bar = b.bar;
        __builtin_amdgcn_s_waitcnt(0);
        const unsigned nloc = b.st[0];
        const unsigned old = xb_add(&bar[XB_XSUB(b.x)], 1u);
        const unsigned gen = old / nloc;
        if (old + 1u == (gen + 1u) * nloc) xb_add(&bar[XB_XGEN(b.x)], 1u);
        else XB_SPIN(xb_ld(&bar[XB_XGEN(b.x)]) == gen, bar);
        __builtin_amdgcn_fence(__ATOMIC_ACQUIRE, "agent");
        asm volatile("s_waitcnt vmcnt(0)" ::: "memory");
    }
    __syncthreads();
}

__global__ void __launch_bounds__(512, 2) yoco_fwd(Args a) {
    extern __shared__ __attribute__((aligned(16))) unsigned char lds_raw[];
    LAS unsigned char* lds = (LAS unsigned char*)lds_raw;
    cg::grid_group grid = cg::this_grid();
    unsigned char* ws = a.ws;
    volatile LAS unsigned* bst = (volatile LAS unsigned*)(lds + 131072 + 1024);
    if (threadIdx.x < 2) bst[threadIdx.x] = 0u;
    __syncthreads();
    XcdBarrier xbar = xcd_barrier_post((unsigned*)ws, bst);
    unsigned* misplaced = (unsigned*)ws + 8192;
    if (threadIdx.x == 0) __hip_atomic_fetch_or(misplaced + 64 * (blockIdx.x % 8u), 1u << xbar.x, __ATOMIC_RELAXED, __HIP_MEMORY_SCOPE_AGENT);
    bool light_ok = false;
    const int lo = a.ph_lo, hi = a.ph_hi, G = gridDim.x, c0 = blockIdx.x;
#define IN(k) (lo <= (k) && (k) < hi)
#define SEAM(k) do { if (IN(k) && IN((k) + 1)) { \
        const bool loc_ = ((k) == 2 || (k) == 3 || (k) == 4 || (k) == 5 || (k) == 7 || (k) == 8 || (k) == 9 || (k) == 12 || (k) == 13 || (k) == 14);     \
        if (loc_ && light_ok) xcc_barrier_light(xbar); else xcd_barrier(xbar); \
        if ((k) == 0) { unsigned all_ = 0u; bool one_ = true; for (int r_ = 0; r_ < 8; ++r_) { const unsigned m_ = __hip_atomic_load(misplaced + 64 * r_, __ATOMIC_RELAXED, __HIP_MEMORY_SCOPE_AGENT); one_ = one_ && (__builtin_popcount(m_) == 1) && ((all_ & m_) == 0u); all_ |= m_; } \
            light_ok = (G % 8 == 0) && one_; } } } while (0)
    if (hi > NPHASE) grid.sync();
    bf16_t* HB = (bf16_t*)(ws + WS_HB); float* SS = (float*)(ws + WS_SS); bf16_t* ACT = (bf16_t*)(ws + WS_ACT);
    const bf16_t* WGU = (const bf16_t*)(ws + WS_WGU); const bf16_t* WD = (const bf16_t*)(ws + WS_WD);
#define GEMM(EpiT, E, Aptr, Bptr, NN, KK, LDA, cc) do { pg8::Gemm g_{(Aptr), (Bptr), M, (NN), (KK), (LDA)}; pg8::StaticOrder S_; S_.init(M, (NN), G, (cc)); \
        pg8::gemm_phase<EpiT, pg8::StaticOrder, true, true>(lds, g_, S_, (E)); } while (0)
    if (IN(0)) { prologue(a, lds); } SEAM(0);
    const int wv = __builtin_amdgcn_readfirstlane(threadIdx.x >> 6);
    const int gu_rem = (64 * 22) % G;
#define IDLE_CONVERT(first, last, nbusy) do { if (c0 >= (nbusy)) convert_items(a, lds, (first), (last), (c0 - (nbusy)) * 8 + wv, (G - (nbusy)) * 8); } while (0)
    if (IN(1)) { EpiGU E{SS, ACT}; GEMM(EpiGU, E, HB, WGU, 2 * DFF, D, D, c0); IDLE_CONVERT(cv::E0, cv::E1, gu_rem); } SEAM(1);
    if (IN(2)) { typedef EpiRes<false, false> EpiT; EpiT E{nullptr, nullptr, HB, SS, 0.5f}; GEMM(EpiT, E, ACT, WD, D, DFF, DFF, c0); } SEAM(2);
    if (IN(3)) { EpiConvIn E{SS, (bf16_t*)(ws + WS_VB), (bf16_t*)(ws + WS_BG)}; GEMM(EpiConvIn, E, HB, (const bf16_t*)(ws + WS_WCIN), 3 * D, D, D, c0); } SEAM(3);
    if (IN(4)) { conv_phase(a); } SEAM(4);
    if (IN(5)) { typedef EpiRes<false, false> EpiT; EpiT E{nullptr, nullptr, HB, SS, 1.0f}; GEMM(EpiT, E, (const bf16_t*)(ws + WS_Y), (const bf16_t*)(ws + WS_WCOUT), D, D, D, c0); } SEAM(5);
    if (IN(6)) { EpiGU E{SS, ACT}; GEMM(EpiGU, E, HB, WGU + WGU_ELEMS, 2 * DFF, D, D, c0); IDLE_CONVERT(cv::E1, cv::E2, gu_rem); } SEAM(6);
    if (IN(7)) { typedef EpiRes<false, false> EpiT; EpiT E{nullptr, nullptr, HB, SS, 0.5f}; GEMM(EpiT, E, ACT, WD + WD_ELEMS, D, DFF, DFF, c0); } SEAM(7);
    if (IN(8)) { { EpiKV E{SS, (bf16_t*)(ws + WS_KV), a.k_norm}; GEMM(EpiKV, E, HB, (const bf16_t*)(ws + WS_WKV), NKV, D, D, c0); }
                 { EpiGU E{SS, ACT}; GEMM(EpiGU, E, HB, WGU + 2 * WGU_ELEMS, 2 * DFF, D, D, (c0 + G / 2) % G); } } SEAM(8);
    if (IN(9)) { typedef EpiRes<false, false> EpiT; EpiT E{nullptr, nullptr, HB, SS, 0.5f}; GEMM(EpiT, E, ACT, WD + 2 * WD_ELEMS, D, DFF, DFF, c0); } SEAM(9);
    if (IN(10)) {
        const bool sep = (G >= 128), cmpblk = sep && c0 >= 64 && c0 < 96;
        const int Gq = sep ? G - 32 : G, wq = sep ? (c0 < 64 ? c0 : c0 - 32) : c0;
        if (!cmpblk) { EpiQG E{SS, (bf16_t*)(ws + WS_QB), (float*)(ws + WS_GATE), a.q_norm};
            pg8::Gemm g_{HB, (const bf16_t*)(ws + WS_WQG), M, NQGP, D, D}; pg8::StaticOrder S_; S_.init(M, NQGP, Gq, wq);
            pg8::gemm_phase<EpiQG, pg8::StaticOrder, true, true>(lds, g_, S_, E); }
        if (!sep || cmpblk) {
            for (int slot = 0; slot < 2; ++slot) { EpiHid E{(const float*)(ws + WS_BIASC) + slot * 256, (bf16_t*)(ws + WS_HID) + (size_t)slot * 4096 * 256};
                pg8::Gemm g_{(const bf16_t*)(ws + WS_KV) + (size_t)slot * KVSLOT, (const bf16_t*)(ws + WS_WC1) + (size_t)slot * 256 * 2048, 4096, 256, 2048, 1024};
                pg8::StaticOrder S_; S_.init(4096, 256, G, (c0 + G - 64 - 16 * slot + G) % G);
                pg8::gemm_phase<EpiHid, pg8::StaticOrder, true, true>(lds, g_, S_, E);
                for (int L = (c0 + G - 64 - 16 * slot + G) % G; L < 16; L += G) { const int pmL = (L % 8) * 2 + L / 8; __syncthreads(); cmp2_unit(a, slot, pmL * 8 + wv); } } }
        const int nb2 = (64 * 5) % Gq;
        if (!cmpblk && wq >= nb2) convert_items(a, lds, cv::E2, cv::E4, (wq - nb2) * 8 + wv, (Gq - nb2) * 8);
    } SEAM(10);
    if (IN(12)) { nsa::nsa_phase(a, (LAS char*)lds); } SEAM(12);
    if (IN(13)) { typedef EpiRes<false, false> EpiT; EpiT E{nullptr, nullptr, HB, SS, 1.0f}; GEMM(EpiT, E, (const bf16_t*)(ws + WS_OB), (const bf16_t*)(ws + WS_WO), D, D, D, c0); } SEAM(13);
    if (IN(14)) { EpiGU E{SS, ACT}; GEMM(EpiGU, E, HB, WGU + 3 * WGU_ELEMS, 2 * DFF, D, D, c0); } SEAM(14);
    if (IN(15)) { typedef EpiRes<false, true> EpiT; EpiT E{nullptr, a.out, HB, nullptr, 0.5f}; GEMM(EpiT, E, ACT, WD + 3 * WD_ELEMS, D, DFF, DFF, c0); }
#undef IN
#undef SEAM
#undef GEMM
}

#ifndef PER_PHASE_LAUNCH
#define PER_PHASE_LAUNCH 0
#endif
extern "C" void kernel_launch(void* const* d_in, const int* in_sizes, int n_in, void* d_out, int out_size, void* d_ws, size_t ws_size, hipStream_t stream) {
    static int grid = 0;
    if (grid == 0) {
        if (n_in != 18 || in_sizes[0] != M * D || out_size != M * D || ws_size < WS_END) { fprintf(stderr, "kernel_launch: unexpected problem (n_in %d, in0 %d, out %d, ws %zu)\n", n_in, n_in > 0 ? in_sizes[0] : -1, out_size, ws_size); grid = -1; return; }
        int dev = 0, cus = 0, per_cu = 0;
        if (hipGetDevice(&dev) != hipSuccess || hipDeviceGetAttribute(&cus, hipDeviceAttributeMultiprocessorCount, dev) != hipSuccess) { grid = -1; return; }
        if (hipFuncSetAttribute((const void*)yoco_fwd, hipFuncAttributeMaxDynamicSharedMemorySize, LDS_BYTES) != hipSuccess) { fprintf(stderr, "kernel_launch: hipFuncSetAttribute failed\n"); grid = -1; return; }
        if (hipOccupancyMaxActiveBlocksPerMultiprocessor(&per_cu, (const void*)yoco_fwd, 512, LDS_BYTES) != hipSuccess || per_cu < 1) { fprintf(stderr, "kernel_launch: occupancy query says %d\n", per_cu); per_cu = 1; }
        (void)hipGetLastError();
        grid = cus;
    }
    if (grid < 0) return;
    Args a{};
    const float** ap = (const float**)&a;
    for (int i = 0; i < 18; ++i) ap[i] = (const float*)d_in[i];
    a.out = (float*)d_out; a.ws = (unsigned char*)d_ws;
#if PER_PHASE_LAUNCH
    for (int p = 0; p < NPHASE; ++p) { a.ph_lo = p; a.ph_hi = p + 1; hipLaunchKernelGGL(yoco_fwd, dim3(grid), dim3(512), LDS_BYTES, stream, a); }
#else
    a.ph_lo = 0; a.ph_hi = NPHASE;
    if (hipMemsetAsync(d_ws, 0, 65536, stream) != hipSuccess) { fprintf(stderr, "kernel_launch: memset failed\n"); return; }
    void* args[] = {&a};
    hipError_t e = hipLaunchCooperativeKernel((const void*)yoco_fwd, dim3(grid), dim3(512), args, LDS_BYTES, stream);
    if (e != hipSuccess) fprintf(stderr, "kernel_launch: cooperative launch failed: %s (grid %d)\n", hipGetErrorString(e), grid);
#endif
}
```

```cpp
#include <hip/hip_runtime.h>
#include <hip/hip_cooperative_groups.h>
#include <cstdio>
#include <cstdint>
namespace cg = cooperative_groups;

#define DI __device__ __forceinline__
#define LAS __attribute__((address_space(3)))
typedef unsigned short bf16_t;
typedef short bf16x8 __attribute__((ext_vector_type(8)));
typedef short s16x4 __attribute__((ext_vector_type(4)));
typedef float f32x2 __attribute__((ext_vector_type(2)));
typedef float f32x4 __attribute__((ext_vector_type(4)));
typedef float f32x16 __attribute__((ext_vector_type(16)));
typedef unsigned u32x2 __attribute__((ext_vector_type(2)));
typedef unsigned u32x4 __attribute__((ext_vector_type(4)));
typedef __bf16 bf16x2_t __attribute__((ext_vector_type(2)));
typedef short v4i16_t __attribute__((ext_vector_type(4)));

DI unsigned pk2(float lo, float hi) { f32x2 v = {lo, hi}; bf16x2_t b = __builtin_convertvector(v, bf16x2_t); return __builtin_bit_cast(unsigned, b); }
DI float bf2f(unsigned short u) { return __uint_as_float((unsigned)u << 16); }
DI float bflo(unsigned w) { return __uint_as_float(w << 16); }
DI float bfhi(unsigned w) { return __uint_as_float(w & 0xffff0000u); }

namespace pg8 {
#define PG8_LAS __attribute__((address_space(3)))
constexpr int BM = 256, BK = 64, HALF = 128, HTB = HALF * BK * 2, STAGE_BYTES = 8 * HTB, NXCD = 8, WGM = 8;
__host__ __device__ __forceinline__ int lds_byte(int r, int c) { const int st = (r >> 4) * 2 + (c >> 5), rr = r & 15, cc = c & 31, ob = rr * 64 + cc * 2; return st * 1024 + (ob ^ (((ob >> 9) & 1) << 5)); }
__host__ __device__ __forceinline__ void stage_rc(int b, int& R, int& C) { const int st = b / 1024, sb = b % 1024, swz = sb ^ (((sb >> 9) & 1) << 5); R = (st >> 1) * 16 + swz / 64; C = (st & 1) * 32 + (swz % 64) / 2; }
__host__ __device__ __forceinline__ int perm32(int rho) { const int n = rho >> 4, i = rho & 15; return 8 * (i >> 2) + 4 * n + (i & 3); }
struct Unit { int pm, pn; };
struct Gemm { const bf16_t* A; const bf16_t* Bt; int M, N, K, lda; };
struct StaticOrder {
    int nM, nN, nwg, G, c;
    __host__ __device__ void init(int M, int N, int G_, int c_) { nM = M / BM; nN = N / BM; nwg = nM * nN; G = G_; c = c_; }
    __host__ __device__ bool next(int i, Unit& u) const {
        const long L = (long)i * G + c; if (L >= nwg) return false;
        int wgid = (int)L; { const int q = nwg / NXCD, r = nwg % NXCD, xcd = wgid % NXCD, off = wgid / NXCD; wgid = (xcd < r ? xcd * (q + 1) : r * (q + 1) + (xcd - r) * q) + off; }
        const int nig = WGM * nN, gid = wgid / nig, fm = gid * WGM, gsz = (nM - fm) < WGM ? (nM - fm) : WGM;
        u.pm = fm + ((wgid % nig) % gsz); u.pn = (wgid % nig) / gsz; return true;
    }
    __device__ __forceinline__ void a_ready(const Unit&) const {}
    __device__ __forceinline__ void done(const Unit&) const {}
};
template <class Epi, class Sched, bool ALIGN_EPI = false, bool SP2 = false>
__device__ __forceinline__ void gemm_phase(PG8_LAS unsigned char* lds, const Gemm g, const Sched& S, const Epi& E) {
    const int tid = threadIdx.x, wid = __builtin_amdgcn_readfirstlane(tid >> 6), lane = tid & 63, wr = wid >> 2, wc = wid & 3, fr = lane & 15, fq = lane >> 4;
    const int K = g.K, nt = K / BK;
    unsigned voffA[2], voffB[2];
#pragma unroll
    for (int i = 0; i < 2; ++i) { int R, C; stage_rc(tid * 16 + i * 8192, R, C); const int Rb = Epi::PERM ? ((R & ~31) + perm32(R & 31)) : R;
        voffA[i] = (unsigned)(R * g.lda + C) * 2u; voffB[i] = (unsigned)(Rb * K + C) * 2u; }
    const size_t kstep = (size_t)(BK * 2);
    const size_t hstepA = (size_t)HALF * g.lda * 2, hstepB = (size_t)HALF * K * 2;
    const size_t tstepA = 2 * hstepA, tstepB = 2 * hstepB;
    const unsigned ldsw = (unsigned)wid * 1024u;
    const int aoff = lds_byte(wr * 64 + fr, fq * 8), boff = lds_byte(wc * 32 + fr, fq * 8);
#define PG8_SA(b, h) (((b) * 2 + (h)) * HTB)
#define PG8_SB(b, h) ((4 + (b) * 2 + (h)) * HTB)
#define PG8_STAGE(bufoff, gbase, voff) do { _Pragma("unroll") for (int _i = 0; _i < 2; ++_i) \
        __builtin_amdgcn_global_load_lds((const unsigned*)((const char*)(gbase) + (voff)[_i]), (PG8_LAS unsigned*)(lds + (bufoff) + ldsw + _i * 8192), 16, 0, 0); } while (0)
#define PG8_LDA(dst, b, h) do { _Pragma("unroll") for (int m = 0; m < 4; ++m) _Pragma("unroll") for (int k = 0; k < 2; ++k) dst[m][k] = *(const PG8_LAS bf16x8*)(lds + PG8_SA(b, h) + aoff + m * 2048 + k * 1024); } while (0)
#define PG8_LDB(dst, b, h) do { _Pragma("unroll") for (int n = 0; n < 2; ++n) _Pragma("unroll") for (int k = 0; k < 2; ++k) dst[n][k] = *(const PG8_LAS bf16x8*)(lds + PG8_SB(b, h) + boff + n * 2048 + k * 1024); } while (0)
#define PG8_MMA(ai, bj, At, Bt) do { __builtin_amdgcn_s_setprio(1); _Pragma("unroll") for (int m = 0; m < 4; ++m) _Pragma("unroll") for (int n = 0; n < 2; ++n) _Pragma("unroll") for (int k = 0; k < 2; ++k) \
        acc[ai][bj][m][n] = __builtin_amdgcn_mfma_f32_16x16x32_bf16(Bt[n][k], At[m][k], acc[ai][bj][m][n], 0, 0, 0); __builtin_amdgcn_s_setprio(0); } while (0)
#define PG8_WAIT_V(n) asm volatile("s_waitcnt vmcnt(" #n ")" ::: "memory")
#define PG8_WAIT_L(n) asm volatile("s_waitcnt lgkmcnt(" #n ")" ::: "memory")
#define PG8_BAR __builtin_amdgcn_s_barrier()
#define PG8_SCHED __builtin_amdgcn_sched_barrier(0)
    Unit cur, nxt; int ui = 0;
    if (!S.next(0, cur)) return;
    f32x4 acc[2][2][4][2];
#pragma unroll
    for (int a = 0; a < 2; ++a)
#pragma unroll
        for (int b = 0; b < 2; ++b)
#pragma unroll
            for (int m = 0; m < 4; ++m)
#pragma unroll
                for (int n = 0; n < 2; ++n) acc[a][b][m][n] = (f32x4){0.f, 0.f, 0.f, 0.f};
    bf16x8 At[4][2], B0[2][2], B1[2][2];
    const char* cA = (const char*)g.A + (size_t)cur.pm * tstepA; const char* cB = (const char*)g.Bt + (size_t)cur.pn * tstepB;
    S.a_ready(cur);
    if constexpr (SP2) {
        PG8_STAGE(PG8_SB(0, 0), cB, voffB); PG8_STAGE(PG8_SB(0, 1), cB + hstepB, voffB); PG8_STAGE(PG8_SA(0, 0), cA, voffA); PG8_STAGE(PG8_SA(0, 1), cA + hstepA, voffA);
        if (wr == 1) PG8_BAR;
        PG8_WAIT_V(2); PG8_BAR;
        PG8_STAGE(PG8_SB(1, 0), cB + kstep, voffB); PG8_STAGE(PG8_SA(1, 0), cA + kstep, voffA); PG8_STAGE(PG8_SB(1, 1), cB + hstepB + kstep, voffB);
        PG8_WAIT_V(6); PG8_BAR;
    } else {
        PG8_STAGE(PG8_SB(0, 0), cB, voffB); PG8_STAGE(PG8_SA(0, 0), cA, voffA); PG8_STAGE(PG8_SB(0, 1), cB + hstepB, voffB); PG8_STAGE(PG8_SA(0, 1), cA + hstepA, voffA);
        if (wr == 1) PG8_BAR;
        PG8_WAIT_V(4); PG8_BAR;
        PG8_STAGE(PG8_SB(1, 0), cB + kstep, voffB); PG8_STAGE(PG8_SA(1, 0), cA + kstep, voffA); PG8_STAGE(PG8_SB(1, 1), cB + hstepB + kstep, voffB);
        PG8_WAIT_V(6); PG8_BAR;
    }
    for (;;) {
        const bool has_next = S.next(ui + 1, nxt);
        const char* nA = has_next ? (const char*)g.A + (size_t)nxt.pm * tstepA : cA; const char* nB = has_next ? (const char*)g.Bt + (size_t)nxt.pn * tstepB : cB;
        for (int t = 0; t < nt; t += 2) {
            const bool last = (t == nt - 2);
            const char* a1 = cA + (size_t)(t + 1) * kstep;
            const char* a2 = last ? nA : cA + (size_t)(t + 2) * kstep; const char* b2 = last ? nB : cB + (size_t)(t + 2) * kstep;
            const char* a3 = a2 + kstep; const char* b3 = b2 + kstep;
            if (last && has_next) S.a_ready(nxt);
            if constexpr (SP2) {
            PG8_LDB(B0, 0, 0); PG8_LDB(B1, 0, 1); PG8_SCHED; PG8_LDA(At, 0, 0); PG8_STAGE(PG8_SA(1, 1), a1 + hstepA, voffA);
            PG8_WAIT_V(8); PG8_WAIT_L(0); PG8_BAR; PG8_MMA(0, 0, At, B0); PG8_MMA(0, 1, At, B1); PG8_BAR; PG8_SCHED;
            PG8_LDA(At, 0, 1); PG8_STAGE(PG8_SB(0, 0), b2, voffB); PG8_STAGE(PG8_SB(0, 1), b2 + hstepB, voffB); PG8_STAGE(PG8_SA(0, 0), a2, voffA);
            PG8_WAIT_V(8); PG8_WAIT_L(0); PG8_BAR; PG8_MMA(1, 0, At, B0); PG8_MMA(1, 1, At, B1); PG8_BAR; PG8_SCHED;
            PG8_LDB(B0, 1, 0); PG8_LDB(B1, 1, 1); PG8_SCHED; PG8_LDA(At, 1, 0); PG8_STAGE(PG8_SA(0, 1), a2 + hstepA, voffA);
            PG8_WAIT_V(8); PG8_WAIT_L(0); PG8_BAR; PG8_MMA(0, 0, At, B0); PG8_MMA(0, 1, At, B1); PG8_BAR; PG8_SCHED;
            PG8_LDA(At, 1, 1); PG8_STAGE(PG8_SB(1, 0), b3, voffB); PG8_STAGE(PG8_SB(1, 1), b3 + hstepB, voffB); PG8_STAGE(PG8_SA(1, 0), a3, voffA);
            PG8_WAIT_V(8); PG8_WAIT_L(0); PG8_BAR; PG8_MMA(1, 0, At, B0); PG8_MMA(1, 1, At, B1); PG8_BAR; PG8_SCHED;
            } else {
            PG8_LDB(B0, 0, 0); PG8_SCHED; PG8_LDA(At, 0, 0); PG8_STAGE(PG8_SA(1, 1), a1 + hstepA, voffA);
            PG8_WAIT_L(8); PG8_BAR; PG8_WAIT_L(0); PG8_MMA(0, 0, At, B0); PG8_BAR; PG8_SCHED;
            PG8_LDB(B1, 0, 1); PG8_STAGE(PG8_SB(0, 0), b2, voffB);
            PG8_BAR; PG8_WAIT_L(0); PG8_MMA(0, 1, At, B1); PG8_BAR;
            PG8_LDA(At, 0, 1); PG8_STAGE(PG8_SA(0, 0), a2, voffA);
            PG8_BAR; PG8_WAIT_L(0); PG8_MMA(1, 0, At, B0); PG8_BAR; PG8_SCHED;
            PG8_STAGE(PG8_SB(0, 1), b2 + hstepB, voffB);
            PG8_WAIT_V(6); PG8_BAR; PG8_MMA(1, 1, At, B1); PG8_BAR;
            PG8_LDB(B0, 1, 0); PG8_SCHED; PG8_LDA(At, 1, 0); PG8_STAGE(PG8_SA(0, 1), a2 + hstepA, voffA);
            PG8_WAIT_L(8); PG8_BAR; PG8_WAIT_L(0); PG8_MMA(0, 0, At, B0); PG8_BAR; PG8_SCHED;
            PG8_LDB(B1, 1, 1); PG8_STAGE(PG8_SB(1, 0), b3, voffB);
            PG8_BAR; PG8_WAIT_L(0); PG8_MMA(0, 1, At, B1); PG8_BAR;
            PG8_LDA(At, 1, 1); PG8_STAGE(PG8_SA(1, 0), a3, voffA);
            PG8_BAR; PG8_WAIT_L(0); PG8_MMA(1, 0, At, B0); PG8_BAR; PG8_SCHED;
            PG8_STAGE(PG8_SB(1, 1), b3 + hstepB, voffB);
            PG8_WAIT_V(6); PG8_BAR; PG8_MMA(1, 1, At, B1); PG8_BAR;
            }
        }
        if constexpr (ALIGN_EPI) { if (wr == 0) PG8_BAR; }
        if constexpr (!Epi::AFTER_DRAIN) { E(acc, cur, wr, wc, fr, fq); S.done(cur); }
        if (!has_next) break;
#pragma unroll
        for (int a = 0; a < 2; ++a)
#pragma unroll
            for (int b = 0; b < 2; ++b)
#pragma unroll
                for (int m = 0; m < 4; ++m)
#pragma unroll
                    for (int n = 0; n < 2; ++n) acc[a][b][m][n] = (f32x4){0.f, 0.f, 0.f, 0.f};
        cur = nxt; cA = nA; cB = nB; ++ui;
        if constexpr (ALIGN_EPI) { if (wr == 1) PG8_BAR; }
    }
    PG8_WAIT_V(0);
    if constexpr (!ALIGN_EPI) { if (wr == 0) PG8_BAR; }
    PG8_BAR;
    if constexpr (Epi::AFTER_DRAIN) { E.fused(acc, cur, wr, wc, fr, fq, lds, wid, lane); S.done(cur); }
#undef PG8_SA
#undef PG8_SB
#undef PG8_STAGE
#undef PG8_LDA
#undef PG8_LDB
#undef PG8_MMA
#undef PG8_WAIT_V
#undef PG8_WAIT_L
#undef PG8_BAR
#undef PG8_SCHED
}
}

constexpr int D = 1024, BATCH = 8, SEQ = 2048, M = BATCH * SEQ, DFF = 2816, NH = 16, HD = 64, NG = 4;
constexpr int NQG = 1072, NQGP = 1280, NKV = 1536, NGATE = 48;
constexpr float EPS = 1e-6f;
constexpr float QSCALE = 0.125f * 1.4426950408889634f;
constexpr float NEG = -1e30f;
constexpr size_t MiB = 1u << 20;
constexpr size_t WS_WGU = 1 * MiB, WS_WD = 45 * MiB, WS_WCIN = 67 * MiB, WS_WCOUT = 73 * MiB, WS_WKV = 75 * MiB, WS_WQG = 78 * MiB, WS_WO = 81 * MiB,
                 WS_WC1 = 83 * MiB, WS_WC2T = 85 * MiB, WS_BIASC = 85 * MiB + 256 * 1024, WS_SS = 86 * MiB, WS_HB = 87 * MiB, WS_H = 119 * MiB,
                 WS_ACT = 183 * MiB, WS_KV = 271 * MiB, WS_HID = 320 * MiB, WS_KCMP = 324 * MiB, WS_VCMP = 324 * MiB + 512 * 1024, WS_END = 325 * MiB;
constexpr size_t WS_VB = WS_ACT, WS_BG = WS_ACT + 32 * MiB, WS_Y = WS_KV;
constexpr size_t WS_QB = WS_ACT, WS_OB = WS_ACT + 32 * MiB, WS_GATE = WS_ACT + 64 * MiB;
constexpr size_t WGU_ELEMS = (size_t)2 * DFF * D, WD_ELEMS = (size_t)D * DFF, KVSLOT = (size_t)M * 256;
constexpr int LDS_BYTES = 147456;
constexpr int NPHASE = 16;

struct Args {
    const float *x, *ffn_norm, *w_gu, *w_down, *mix_norm, *conv_w_in, *conv_w, *conv_w_out, *kv_norm, *kv_w, *cmp_pos, *cmp_w1, *cmp_b1, *cmp_w2, *k_norm, *w_qg, *q_norm, *w_o;
    float* out; unsigned char* ws; int ph_lo, ph_hi;
};

DI float rstd_row(const float* SS, int row, int fq) {
    const f32x4 v = *(const f32x4*)(SS + (size_t)row * 16 + 4 * fq);
    float s = (v.x + v.y) + (v.z + v.w); s += __shfl_xor(s, 16); s += __shfl_xor(s, 32);
    return rsqrtf(s * (1.f / D) + EPS);
}
DI float sigm(float a) { return __builtin_amdgcn_rcpf(1.f + __expf(-a)); }
DI void rstd_rows(float (&rs)[2][4], const float* SS, int row0, int fq) {
    f32x4 v[2][4];
#pragma unroll
    for (int ai = 0; ai < 2; ++ai)
#pragma unroll
        for (int m = 0; m < 4; ++m) v[ai][m] = *(const f32x4*)(SS + (size_t)(row0 + ai * 128 + m * 16) * 16 + 4 * fq);
#pragma unroll
    for (int ai = 0; ai < 2; ++ai)
#pragma unroll
        for (int m = 0; m < 4; ++m) { float t = (v[ai][m].x + v[ai][m].y) + (v[ai][m].z + v[ai][m].w); t += __shfl_xor(t, 16); t += __shfl_xor(t, 32); rs[ai][m] = rsqrtf(t * (1.f / D) + EPS); }
}

struct EpiGU {
    static constexpr bool PERM = true, AFTER_DRAIN = false; const float* SS; bf16_t* ACT;
    DI void operator()(const f32x4 (&acc)[2][2][4][2], const pg8::Unit& u, int wr, int wc, int fr, int fq) const {
        const int row0 = u.pm * 256 + wr * 64 + fr; float rs[2][4]; rstd_rows(rs, SS, row0, fq);
        bf16_t* dst = ACT + (size_t)row0 * DFF + u.pn * 128 + wc * 32 + 8 * fq;
#pragma unroll
        for (int ai = 0; ai < 2; ++ai)
#pragma unroll
            for (int m = 0; m < 4; ++m) { const float r1 = rs[ai][m], r2 = r1 * r1, k1 = -1.4426950408889634f * r1; float o[8];
#pragma unroll
                for (int n = 0; n < 2; ++n)
#pragma unroll
                    for (int i = 0; i < 4; ++i) { const float ga = acc[ai][0][m][n][i], up = acc[ai][1][m][n][i];
                        o[4 * n + i] = (ga * up) * (r2 * __builtin_amdgcn_rcpf(1.f + __builtin_amdgcn_exp2f(ga * k1))); }
                u32x4 w; w.x = pk2(o[0], o[1]); w.y = pk2(o[2], o[3]); w.z = pk2(o[4], o[5]); w.w = pk2(o[6], o[7]);
                *(u32x4*)(dst + (size_t)(ai * 128 + m * 16) * DFF) = w; }
    }
};
template <bool SRC32, bool DST32> struct EpiRes {
    static constexpr bool PERM = true, AFTER_DRAIN = false; const float* src32; float* dst32; bf16_t* HB; float* SS; float scale;
    DI void operator()(const f32x4 (&acc)[2][2][4][2], const pg8::Unit& u, int wr, int wc, int fr, int fq) const {
#pragma unroll
        for (int ai = 0; ai < 2; ++ai) {
            const int row0 = u.pm * 256 + ai * 128 + wr * 64 + fr; const size_t off0 = (size_t)row0 * D + u.pn * 256 + wc * 32 + 8 * fq;
            f32x4 hv[4][2][2];
            if constexpr (SRC32) {
#pragma unroll
                for (int m = 0; m < 4; ++m)
#pragma unroll
                    for (int bj = 0; bj < 2; ++bj) { hv[m][bj][0] = *(const f32x4*)(src32 + off0 + (size_t)m * 16 * D + bj * 128); hv[m][bj][1] = *(const f32x4*)(src32 + off0 + (size_t)m * 16 * D + bj * 128 + 4); }
            } else {
                u32x4 hw[4][2];
#pragma unroll
                for (int m = 0; m < 4; ++m)
#pragma unroll
                    for (int bj = 0; bj < 2; ++bj) hw[m][bj] = *(const u32x4*)(HB + off0 + (size_t)m * 16 * D + bj * 128);
#pragma unroll
                for (int m = 0; m < 4; ++m)
#pragma unroll
                    for (int bj = 0; bj < 2; ++bj) { const u32x4 w = hw[m][bj]; hv[m][bj][0] = (f32x4){bflo(w.x), bfhi(w.x), bflo(w.y), bfhi(w.y)}; hv[m][bj][1] = (f32x4){bflo(w.z), bfhi(w.z), bflo(w.w), bfhi(w.w)}; }
            }
#pragma unroll
            for (int m = 0; m < 4; ++m) { float ssq = 0.f;
#pragma unroll
                for (int bj = 0; bj < 2; ++bj) { const size_t off = off0 + (size_t)m * 16 * D + bj * 128;
                    const f32x4 o0 = hv[m][bj][0] + acc[ai][bj][m][0] * scale, o1 = hv[m][bj][1] + acc[ai][bj][m][1] * scale;
                    if constexpr (DST32) { *(f32x4*)(dst32 + off) = o0; *(f32x4*)(dst32 + off + 4) = o1; }
                    else { ssq += (o0.x * o0.x + o0.y * o0.y) + (o0.z * o0.z + o0.w * o0.w) + (o1.x * o1.x + o1.y * o1.y) + (o1.z * o1.z + o1.w * o1.w);
                        u32x4 w; w.x = pk2(o0.x, o0.y); w.y = pk2(o0.z, o0.w); w.z = pk2(o1.x, o1.y); w.w = pk2(o1.z, o1.w); *(u32x4*)(HB + off) = w; } }
                if constexpr (!DST32) { ssq += __shfl_xor(ssq, 16); ssq += __shfl_xor(ssq, 32); if (fq == 0) SS[(size_t)(row0 + m * 16) * 16 + u.pn * 4 + wc] = ssq; } }
        }
    }
};
struct EpiConvIn {
    static constexpr bool PERM = true, AFTER_DRAIN = false; const float* SS; bf16_t* VB; bf16_t* BG;
    DI void operator()(const f32x4 (&acc)[2][2][4][2], const pg8::Unit& u, int wr, int wc, int fr, int fq) const {
        const int row0 = u.pm * 256 + wr * 64 + fr; float rs[2][4]; rstd_rows(rs, SS, row0, fq);
#pragma unroll
        for (int ai = 0; ai < 2; ++ai)
#pragma unroll
            for (int m = 0; m < 4; ++m) { const int row = row0 + ai * 128 + m * 16; const float r1 = rs[ai][m];
                if (u.pn < 8) { const float r2 = r1 * r1; const f32x4 v0 = acc[ai][0][m][0] * acc[ai][1][m][0] * r2, v1 = acc[ai][0][m][1] * acc[ai][1][m][1] * r2;
                    u32x4 w; w.x = pk2(v0.x, v0.y); w.y = pk2(v0.z, v0.w); w.z = pk2(v1.x, v1.y); w.w = pk2(v1.z, v1.w);
                    *(u32x4*)(VB + (size_t)row * D + u.pn * 128 + wc * 32 + 8 * fq) = w; }
                else {
#pragma unroll
                    for (int bj = 0; bj < 2; ++bj) { const f32x4 a = acc[ai][bj][m][0] * r1, b = acc[ai][bj][m][1] * r1;
                        u32x4 w; w.x = pk2(a.x, a.y); w.y = pk2(a.z, a.w); w.z = pk2(b.x, b.y); w.w = pk2(b.z, b.w);
                        *(u32x4*)(BG + (size_t)row * D + (u.pn - 8) * 256 + bj * 128 + wc * 32 + 8 * fq) = w; } } }
    }
};
struct EpiKV {
    static constexpr bool PERM = true, AFTER_DRAIN = false; const float* SS; bf16_t* KV; const float* knorm;
    DI void operator()(const f32x4 (&acc)[2][2][4][2], const pg8::Unit& u, int wr, int wc, int fr, int fq) const {
        const int slot = u.pn; const bool nrm = (slot == 2) || (slot == 4); const float* gn = knorm + (slot == 2 ? 64 : 128);
        f32x4 gv[2][2];
#pragma unroll
        for (int bj = 0; bj < 2; ++bj)
#pragma unroll
            for (int n = 0; n < 2; ++n) gv[bj][n] = nrm ? *(const f32x4*)(gn + bj * 32 + 8 * fq + 4 * n) : (f32x4){1.f, 1.f, 1.f, 1.f};
        float rsv[2][4]; rstd_rows(rsv, SS, u.pm * 256 + wr * 64 + fr, fq);
#pragma unroll
        for (int ai = 0; ai < 2; ++ai)
#pragma unroll
            for (int m = 0; m < 4; ++m) { const int row = u.pm * 256 + ai * 128 + wr * 64 + m * 16 + fr; const float rs = rsv[ai][m];
                f32x4 x[2][2]; float ss = 0.f;
#pragma unroll
                for (int bj = 0; bj < 2; ++bj)
#pragma unroll
                    for (int n = 0; n < 2; ++n) { x[bj][n] = acc[ai][bj][m][n] * rs; const f32x4 q = x[bj][n] * x[bj][n]; ss += (q.x + q.y) + (q.z + q.w); }
                ss += __shfl_xor(ss, 16); ss += __shfl_xor(ss, 32);
                const float rn = nrm ? rsqrtf(ss * (1.f / HD) + EPS) : 1.f;
                const int b = row >> 11, s = row & 2047;
                bf16_t* dst = KV + (size_t)slot * KVSLOT + ((size_t)(b * 4 + wc) * SEQ + s) * HD + 8 * fq;
#pragma unroll
                for (int bj = 0; bj < 2; ++bj) { const f32x4 y0 = x[bj][0] * gv[bj][0] * rn, y1 = x[bj][1] * gv[bj][1] * rn;
                    u32x4 w; w.x = pk2(y0.x, y0.y); w.y = pk2(y0.z, y0.w); w.z = pk2(y1.x, y1.y); w.w = pk2(y1.z, y1.w); *(u32x4*)(dst + bj * 32) = w; } }
    }
};
struct EpiQG {
    static constexpr bool PERM = true, AFTER_DRAIN = false; const float* SS; bf16_t* QB; float* GATE; const float* qnorm;
    DI void operator()(const f32x4 (&acc)[2][2][4][2], const pg8::Unit& u, int wr, int wc, int fr, int fq) const {
        f32x4 gv[2][2];
#pragma unroll
        for (int bj = 0; bj < 2; ++bj)
#pragma unroll
            for (int n = 0; n < 2; ++n) gv[bj][n] = *(const f32x4*)(qnorm + bj * 32 + 8 * fq + 4 * n);
        float rsv[2][4]; rstd_rows(rsv, SS, u.pm * 256 + wr * 64 + fr, fq);
#pragma unroll
        for (int ai = 0; ai < 2; ++ai)
#pragma unroll
            for (int m = 0; m < 4; ++m) { const int row = u.pm * 256 + ai * 128 + wr * 64 + m * 16 + fr; const float rs = rsv[ai][m];
                if (u.pn < 4) {
                    f32x4 x[2][2]; float ss = 0.f;
#pragma unroll
                    for (int bj = 0; bj < 2; ++bj)
#pragma unroll
                        for (int n = 0; n < 2; ++n) { x[bj][n] = acc[ai][bj][m][n] * rs; const f32x4 q = x[bj][n] * x[bj][n]; ss += (q.x + q.y) + (q.z + q.w); }
                    ss += __shfl_xor(ss, 16); ss += __shfl_xor(ss, 32);
                    const float rn = rsqrtf(ss * (1.f / HD) + EPS) * QSCALE;
                    bf16_t* dst = QB + (size_t)row * D + (u.pn * 4 + wc) * HD + 8 * fq;
#pragma unroll
                    for (int bj = 0; bj < 2; ++bj) { const f32x4 y0 = x[bj][0] * gv[bj][0] * rn, y1 = x[bj][1] * gv[bj][1] * rn;
                        u32x4 w; w.x = pk2(y0.x, y0.y); w.y = pk2(y0.z, y0.w); w.z = pk2(y1.x, y1.y); w.w = pk2(y1.z, y1.w); *(u32x4*)(dst + bj * 32) = w; }
                } else {
#pragma unroll
                    for (int n = 0; n < 2; ++n) { const int c = wc * 32 + 8 * fq + 4 * n;
                        if (c < NGATE) { const f32x4 v = acc[ai][0][m][n] * rs; f32x4 o; o.x = sigm(v.x); o.y = sigm(v.y); o.z = sigm(v.z); o.w = sigm(v.w);
                            *(f32x4*)(GATE + (size_t)row * NGATE + c) = o; } }
                } }
    }
};
struct EpiHid {
    static constexpr bool PERM = true, AFTER_DRAIN = false; const float* bias; bf16_t* HID;
    DI static float gelu(float x) { const float z2 = 1.5957691216f * (x + 0.044715f * x * x * x); return x * sigm(z2); }
    DI void operator()(const f32x4 (&acc)[2][2][4][2], const pg8::Unit& u, int wr, int wc, int fr, int fq) const {
#pragma unroll
        for (int ai = 0; ai < 2; ++ai)
#pragma unroll
            for (int m = 0; m < 4; ++m) { const int row = u.pm * 256 + ai * 128 + wr * 64 + m * 16 + fr;
#pragma unroll
                for (int bj = 0; bj < 2; ++bj) { const int col0 = bj * 128 + wc * 32 + 8 * fq;
                    const f32x4 v0 = acc[ai][bj][m][0] + *(const f32x4*)(bias + col0), v1 = acc[ai][bj][m][1] + *(const f32x4*)(bias + col0 + 4);
                    u32x4 w; w.x = pk2(gelu(v0.x), gelu(v0.y)); w.y = pk2(gelu(v0.z), gelu(v0.w)); w.z = pk2(gelu(v1.x), gelu(v1.y)); w.w = pk2(gelu(v1.z), gelu(v1.w));
                    *(u32x4*)(HID + (size_t)row * 256 + col0) = w; } }
    }
};

DI int colmap(int mapid, int p) {
    if (mapid == 1) { const int j = (p >> 8) * 128 + (p & 127); return ((p >> 7) & 1) ? DFF + j : j; }
    if (mapid == 2) { if (p < 2048) { const int j = (p >> 8) * 128 + (p & 127); return ((p >> 7) & 1) ? 2048 + j : 1024 + j; } return p - 2048; }
    if (mapid == 3 || (mapid == 4 && p < 1024)) { const int t = p >> 8, q = p & 255; return t * 256 + ((q >> 5) & 3) * 64 + (q >> 7) * 32 + (q & 31); }
    if (mapid == 4) return p < NQG ? p : -1;
    return p;
}
struct Job { const float* W; bf16_t* WT; const float* gain; int K, Nsrc, P, mapid; };
DI void transpose_item(const Job& j, int item, LAS float* scr, int lane) {
    const int nblk = j.P / 32, kb = item / nblk, nb = item % nblk, k0 = 64 * kb, p0 = 32 * nb;
    const int L = colmap(j.mapid, p0 + (lane & 31));
    float v[32];
#pragma unroll
    for (int i = 0; i < 32; ++i) { const int kk = 2 * i + (lane >> 5); v[i] = (L >= 0) ? j.W[(size_t)(k0 + kk) * j.Nsrc + L] : 0.f; }
    if (j.gain) {
#pragma unroll
        for (int i = 0; i < 32; ++i) v[i] *= j.gain[k0 + 2 * i + (lane >> 5)]; }
#pragma unroll
    for (int i = 0; i < 32; ++i) scr[(2 * i + (lane >> 5)) * 33 + (lane & 31)] = v[i];
    asm volatile("s_waitcnt lgkmcnt(0)" ::: "memory");
    const int c = lane & 7;
#pragma unroll
    for (int q = 0; q < 4; ++q) { const int n = (lane >> 3) + 8 * q; const LAS float* s = scr + (8 * c) * 33 + n;
        u32x4 o; o.x = pk2(s[0 * 33], s[1 * 33]); o.y = pk2(s[2 * 33], s[3 * 33]); o.z = pk2(s[4 * 33], s[5 * 33]); o.w = pk2(s[6 * 33], s[7 * 33]);
        *(u32x4*)(j.WT + (size_t)(p0 + n) * j.K + k0 + 8 * c) = o; }
    asm volatile("s_waitcnt lgkmcnt(0)" ::: "memory");
}
DI float wave_sum(float v) {
#pragma unroll
    for (int o = 1; o < 64; o <<= 1) v += __shfl_xor(v, o);
    return v;
}
namespace cv {
constexpr int I_GU = 16 * 176, I_D = 44 * 32, I_CIN = 16 * 96, I_SQ = 16 * 32, I_KV = 16 * 48, I_QG = 16 * 40, I_C1 = 32 * 8, I_C2 = 4 * 2;
constexpr int E0 = I_GU;
constexpr int E1 = E0 + I_D + I_CIN + I_SQ + I_GU;
constexpr int E2 = E1 + I_D + I_KV + I_GU + I_D + I_QG + 2 * I_C1 + 2 * I_C2;
constexpr int E3 = E2 + I_SQ + I_GU;
constexpr int E4 = E3 + I_D;
}
DI void convert_items(const Args& a, LAS unsigned char* lds, int first, int last, int worker, int nworkers) {
    using namespace cv;
    const int lane = threadIdx.x & 63, wave = __builtin_amdgcn_readfirstlane(threadIdx.x >> 6);
    LAS float* scr = (LAS float*)(lds + wave * 16384);
    unsigned char* ws = a.ws;
    for (int it = first + worker; it < last; it += nworkers) {
        int r = it; Job j;
#define GUJ(q) Job{a.w_gu + (size_t)(q) * WGU_ELEMS, (bf16_t*)(ws + WS_WGU) + (size_t)(q) * WGU_ELEMS, a.ffn_norm + (q) * D, D, 2 * DFF, 2 * DFF, 1}
#define DJ(q) Job{a.w_down + (size_t)(q) * WD_ELEMS, (bf16_t*)(ws + WS_WD) + (size_t)(q) * WD_ELEMS, nullptr, DFF, D, D, 0}
        if (r < I_GU) { j = GUJ(0); }
        else if ((r -= I_GU) < I_D) { j = DJ(0); }
        else if ((r -= I_D) < I_CIN) { j = Job{a.conv_w_in, (bf16_t*)(ws + WS_WCIN), a.mix_norm, D, 3 * D, 3 * D, 2}; }
        else if ((r -= I_CIN) < I_SQ) { j = Job{a.conv_w_out, (bf16_t*)(ws + WS_WCOUT), nullptr, D, D, D, 0}; }
        else if ((r -= I_SQ) < I_GU) { j = GUJ(1); }
        else if ((r -= I_GU) < I_D) { j = DJ(1); }
        else if ((r -= I_D) < I_KV) { j = Job{a.kv_w, (bf16_t*)(ws + WS_WKV), a.kv_norm, D, NKV, NKV, 3}; }
        else if ((r -= I_KV) < I_GU) { j = GUJ(2); }
        else if ((r -= I_GU) < I_D) { j = DJ(2); }
        else if ((r -= I_D) < I_QG) { j = Job{a.w_qg, (bf16_t*)(ws + WS_WQG), a.mix_norm + D, D, NQG, NQGP, 4}; }
        else if ((r -= I_QG) < 2 * I_C1) { const int q = r / I_C1; r -= q * I_C1; j = Job{a.cmp_w1 + (size_t)q * 2048 * 256, (bf16_t*)(ws + WS_WC1) + (size_t)q * 2048 * 256, nullptr, 2048, 256, 256, 0}; }
        else if ((r -= 2 * I_C1) < 2 * I_C2) { const int q = r / I_C2; r -= q * I_C2; j = Job{a.cmp_w2 + (size_t)q * 256 * 64, (bf16_t*)(ws + WS_WC2T) + (size_t)q * 256 * 64, nullptr, 256, 64, 64, 0}; }
        else if ((r -= 2 * I_C2) < I_SQ) { j = Job{a.w_o, (bf16_t*)(ws + WS_WO), nullptr, D, D, D, 0}; }
        else if ((r -= I_SQ) < I_GU) { j = GUJ(3); }
        else { r -= I_GU; j = DJ(3); }
#undef GUJ
#undef DJ
        transpose_item(j, r, scr, lane);
    }
}
DI void prologue(const Args& a, LAS unsigned char* lds) {
    const int tid = threadIdx.x, lane = tid & 63, wave = __builtin_amdgcn_readfirstlane(tid >> 6);
    const int gw = blockIdx.x * 8 + wave, NGW = gridDim.x * 8;
    unsigned char* ws = a.ws;
    convert_items(a, lds, 0, cv::E0, gw, NGW);
    bf16_t* HB = (bf16_t*)(ws + WS_HB); float* SS = (float*)(ws + WS_SS);
    for (int m0 = gw * 4; m0 < M; m0 += NGW * 4) {
        f32x4 v[4][4];
#pragma unroll
        for (int rr = 0; rr < 4; ++rr)
#pragma unroll
            for (int q = 0; q < 4; ++q) v[rr][q] = *((const f32x4*)(a.x + (size_t)(m0 + rr) * D) + lane + 64 * q);
#pragma unroll
        for (int rr = 0; rr < 4; ++rr) { float s = 0.f; unsigned long long* o8 = (unsigned long long*)(HB + (size_t)(m0 + rr) * D) + lane;
#pragma unroll
            for (int q = 0; q < 4; ++q) { const f32x4 w = v[rr][q]; s += (w.x * w.x + w.y * w.y) + (w.z * w.z + w.w * w.w);
                o8[64 * q] = (unsigned long long)pk2(w.x, w.y) | ((unsigned long long)pk2(w.z, w.w) << 32); }
            s = wave_sum(s);
            if (lane < 16) SS[(size_t)(m0 + rr) * 16 + lane] = (lane == 0) ? s : 0.f; }
    }
    for (int c = gw; c < 512; c += NGW) { const int slot = c >> 8, col = c & 255; float s = 0.f;
        const float* pos = a.cmp_pos + slot * 2048; const float* w1 = a.cmp_w1 + (size_t)slot * 2048 * 256 + col;
        for (int k = lane; k < 2048; k += 64) s += pos[k] * w1[(size_t)k * 256];
        s = wave_sum(s);
        if (lane == 0) ((float*)(ws + WS_BIASC))[c] = s + a.cmp_b1[c]; }
}

DI void conv_phase(const Args& a) {
    const bf16_t* VB = (const bf16_t*)(a.ws + WS_VB); const bf16_t* BG = (const bf16_t*)(a.ws + WS_BG); bf16_t* Y = (bf16_t*)(a.ws + WS_Y);
    const bool byx = (gridDim.x % 8 == 0);
    const int ibase = byx ? (int)(blockIdx.x % 8) * (M / 8) * 128 : 0, iend = byx ? ibase + (M / 8) * 128 : M * 128;
    const int nth = byx ? (int)(gridDim.x / 8) * 512 : (int)gridDim.x * 512, ifirst = ibase + (byx ? (int)(blockIdx.x / 8) : (int)blockIdx.x) * 512 + (int)threadIdx.x;
    for (int idx = ifirst; idx < iend; idx += nth) {
        const int m = idx >> 7, k0 = (idx & 127) * 8, s = m & (SEQ - 1); const size_t off = (size_t)m * D + k0;
        const u32x4 z = {0u, 0u, 0u, 0u};
        const u32x4 v0 = *(const u32x4*)(VB + off), v1 = s >= 1 ? *(const u32x4*)(VB + off - D) : z, v2 = s >= 2 ? *(const u32x4*)(VB + off - 2 * D) : z, bg = *(const u32x4*)(BG + off);
        const f32x4 c0a = *(const f32x4*)(a.conv_w + k0), c0b = *(const f32x4*)(a.conv_w + k0 + 4), c1a = *(const f32x4*)(a.conv_w + D + k0), c1b = *(const f32x4*)(a.conv_w + D + k0 + 4),
                    c2a = *(const f32x4*)(a.conv_w + 2 * D + k0), c2b = *(const f32x4*)(a.conv_w + 2 * D + k0 + 4);
        float w0[8] = {c0a.x, c0a.y, c0a.z, c0a.w, c0b.x, c0b.y, c0b.z, c0b.w}, w1[8] = {c1a.x, c1a.y, c1a.z, c1a.w, c1b.x, c1b.y, c1b.z, c1b.w}, w2[8] = {c2a.x, c2a.y, c2a.z, c2a.w, c2b.x, c2b.y, c2b.z, c2b.w};
        u32x4 o;
#pragma unroll
        for (int q = 0; q < 4; ++q) {
            const float lo = bflo(bg[q]) * (w0[2 * q] * bflo(v2[q]) + w1[2 * q] * bflo(v1[q]) + w2[2 * q] * bflo(v0[q]));
            const float hi = bfhi(bg[q]) * (w0[2 * q + 1] * bfhi(v2[q]) + w1[2 * q + 1] * bfhi(v1[q]) + w2[2 * q + 1] * bfhi(v0[q]));
            o[q] = pk2(lo, hi); }
        *(u32x4*)(Y + off) = o;
    }
}

DI int crow(int reg, int h) { return (reg & 3) + 8 * (reg >> 2) + 4 * h; }
#define MFMA32(a, b, c) __builtin_amdgcn_mfma_f32_32x32x16_bf16((a), (b), (c), 0, 0, 0)
DI void cmp2_unit(const Args& a, int slot, int rg) {
    const int tid = threadIdx.x, lane = tid & 63, r = lane & 31, h = lane >> 5;
    {
        const bf16_t* HID = (const bf16_t*)(a.ws + WS_HID) + (size_t)slot * 4096 * 256 + (size_t)(32 * rg + r) * 256 + 8 * h;
        const bf16_t* W2T = (const bf16_t*)(a.ws + WS_WC2T) + (size_t)slot * 64 * 256 + (size_t)r * 256 + 8 * h;
        f32x16 o[2]; o[0] = f32x16{}; o[1] = f32x16{};
#pragma unroll 4
        for (int kk = 0; kk < 16; ++kk) { const bf16x8 hb = *(const bf16x8*)(HID + 16 * kk);
            const bf16x8 w0 = *(const bf16x8*)(W2T + 16 * kk), w1 = *(const bf16x8*)(W2T + 32 * 256 + 16 * kk);
            o[0] = MFMA32(w0, hb, o[0]); o[1] = MFMA32(w1, hb, o[1]); }
        float rn = 1.f;
        if (slot == 0) { float ss = 0.f;
#pragma unroll
            for (int dt = 0; dt < 2; ++dt)
#pragma unroll
                for (int q = 0; q < 16; ++q) ss += o[dt][q] * o[dt][q];
            ss += __shfl_xor(ss, 32); rn = rsqrtf(ss * (1.f / HD) + EPS); }
        bf16_t* dst = (bf16_t*)(a.ws + (slot == 0 ? WS_KCMP : WS_VCMP)) + (size_t)(32 * rg + r) * 64;
#pragma unroll
        for (int dt = 0; dt < 2; ++dt)
#pragma unroll
            for (int gq = 0; gq < 4; ++gq) { const int d = 32 * dt + 8 * gq + 4 * h; f32x4 g = {1.f, 1.f, 1.f, 1.f}; if (slot == 0) g = *(const f32x4*)(a.k_norm + d);
                u32x2 w; w.x = pk2(o[dt][4 * gq] * rn * g.x, o[dt][4 * gq + 1] * rn * g.y); w.y = pk2(o[dt][4 * gq + 2] * rn * g.z, o[dt][4 * gq + 3] * rn * g.w);
                *(u32x2*)(dst + d) = w; }
    }
}

namespace nsa {
constexpr int ROWB = 144;
constexpr int TILEB = 64 * ROWB;
constexpr int L_KV = 0;
constexpr int L_S4 = 36864;
constexpr int L_LS = L_S4 + 4 * 64 * 33 * 4;
constexpr int L_IMP = L_LS + 4 * 64 * 33 * 4;
constexpr int L_SELM = L_IMP + 64 * 33 * 4;
constexpr int L_END = L_SELM + 65 * 4;
static_assert(L_END <= 131072, "nsa LDS map");
DI s16x4 vtr(LAS const char* p) { return __builtin_bit_cast(s16x4, __builtin_amdgcn_ds_read_tr16_b64_v4i16((LAS v4i16_t*)p)); }
DI void qk_tile(f32x16& st, LAS const char* kb, const bf16x8 (&qf)[4]) {
    st = f32x16{};
#pragma unroll
    for (int kk = 0; kk < 4; ++kk) { const bf16x8 kf = *(LAS const bf16x8*)(kb + kk * 32); st = MFMA32(kf, qf[kk], st); }
}
DI void pv_tile(f32x16 (&o)[2], const f32x16& p, LAS const char* vb) {
#pragma unroll
    for (int s = 0; s < 2; ++s) {
        u32x4 w; w.x = pk2(p[8 * s], p[8 * s + 1]); w.y = pk2(p[8 * s + 2], p[8 * s + 3]); w.z = pk2(p[8 * s + 4], p[8 * s + 5]); w.w = pk2(p[8 * s + 6], p[8 * s + 7]);
        const bf16x8 pb = __builtin_bit_cast(bf16x8, w);
#pragma unroll
        for (int dt = 0; dt < 2; ++dt) { const s16x4 lo = vtr(vb + (16 * s) * ROWB + dt * 64), hi = vtr(vb + (16 * s + 8) * ROWB + dt * 64);
            const bf16x8 va = __builtin_shufflevector(lo, hi, 0, 1, 2, 3, 4, 5, 6, 7);
            o[dt] = MFMA32(va, pb, o[dt]); }
    }
}
DI void nsa_step(LAS char* lds, int i, int j_cur, int n_sel, int tb, unsigned selm, int tlh, float g1, int koff, int voff, const bf16x8 (&qf)[4],
                 f32x16 (&acc)[2], f32x16 (&tot)[2], float& l_run) {
    if (i == n_sel) {
        const float lt = l_run + __shfl_xor(l_run, 32); const float sc = g1 / lt;
        tot[0] += acc[0] * sc; tot[1] += acc[1] * sc; acc[0] = f32x16{}; acc[1] = f32x16{}; l_run = 0.f; }
    const bool is_win = (i >= n_sel);
    const bool lane_ok = is_win ? true : (((selm >> j_cur) & 1u) != 0u);
    if (__any(lane_ok)) {
        LAS const char* kbuf = lds + L_KV + (i & 1) * 2 * TILEB; LAS const char* vbuf = kbuf + TILEB;
        bf16x8 kf[2][4]; s16x4 vlo[2][2][2], vhi[2][2][2];
#pragma unroll
        for (int c = 0; c < 2; ++c)
#pragma unroll
            for (int kk = 0; kk < 4; ++kk) kf[c][kk] = *(LAS const bf16x8*)(kbuf + (32 * c) * ROWB + koff + kk * 32);
        __builtin_amdgcn_sched_barrier(0);
        f32x16 st[2]; st[0] = f32x16{}; st[1] = f32x16{};
#pragma unroll
        for (int kk = 0; kk < 4; ++kk) { st[0] = MFMA32(kf[0][kk], qf[kk], st[0]); st[1] = MFMA32(kf[1][kk], qf[kk], st[1]); }
        __builtin_amdgcn_sched_barrier(0);
#pragma unroll
        for (int c = 0; c < 2; ++c)
#pragma unroll
            for (int sx = 0; sx < 2; ++sx)
#pragma unroll
                for (int dt = 0; dt < 2; ++dt) { vlo[c][sx][dt] = vtr(vbuf + voff + (32 * c + 16 * sx) * ROWB + dt * 64); vhi[c][sx][dt] = vtr(vbuf + voff + (32 * c + 16 * sx + 8) * ROWB + dt * 64); }
        __builtin_amdgcn_sched_barrier(0);
        const bool causal = (j_cur == tb), lower = is_win && (j_cur == tb - 8);
        if (causal || lower || !__all(lane_ok)) {
#pragma unroll
            for (int c = 0; c < 2; ++c)
#pragma unroll
                for (int q = 0; q < 16; ++q) { const int kl = 32 * c + crow(q, 0);
                    const bool masked = (!lane_ok) || (causal && kl > tlh) || (lower && kl <= tlh);
                    if (masked) st[c][q] = NEG; }
        }
        float ls0 = 0.f, ls1 = 0.f;
#pragma unroll
        for (int q = 0; q < 16; ++q) { const float p0 = __builtin_amdgcn_exp2f(st[0][q]), p1 = __builtin_amdgcn_exp2f(st[1][q]); st[0][q] = p0; st[1][q] = p1; ls0 += p0; ls1 += p1; }
        l_run += ls0 + ls1;
#pragma unroll
        for (int c = 0; c < 2; ++c)
#pragma unroll
            for (int sx = 0; sx < 2; ++sx) {
                u32x4 w; w.x = pk2(st[c][8 * sx], st[c][8 * sx + 1]); w.y = pk2(st[c][8 * sx + 2], st[c][8 * sx + 3]); w.z = pk2(st[c][8 * sx + 4], st[c][8 * sx + 5]); w.w = pk2(st[c][8 * sx + 6], st[c][8 * sx + 7]);
                const bf16x8 pb = __builtin_bit_cast(bf16x8, w);
#pragma unroll
                for (int dt = 0; dt < 2; ++dt) { const bf16x8 va = __builtin_shufflevector(vlo[c][sx][dt], vhi[c][sx][dt], 0, 1, 2, 3, 4, 5, 6, 7); acc[dt] = MFMA32(va, pb, acc[dt]); } }
    }
}
DI void nsa_unit(LAS char* lds, int b, int g, int tb, const bf16_t* QB, const float* GATE, const bf16_t* KV, const bf16_t* KCMP, const bf16_t* VCMP, bf16_t* OB) {
    const int tid = threadIdx.x, lane = tid & 63, wave = __builtin_amdgcn_readfirstlane(tid >> 6), r = lane & 31, h = lane >> 5;
    const int hh = wave & 3, th = wave >> 2, head = g * 4 + hh, bg = b * 4 + g;
    const int t0 = tb * 64, tl = th * 32 + r, t = t0 + tl; const size_t m = (size_t)b * SEQ + t;
    bf16x8 qf[4];
#pragma unroll
    for (int kk = 0; kk < 4; ++kk) qf[kk] = *(const bf16x8*)(QB + m * D + head * HD + kk * 16 + h * 8);
    const float g0 = GATE[m * NGATE + head * 3 + 0], g1 = GATE[m * NGATE + head * 3 + 1], g2 = GATE[m * NGATE + head * 3 + 2];
    const bf16_t* Ksel = KV + 2 * KVSLOT + (size_t)bg * SEQ * HD + tid * 8; const bf16_t* Kwin = KV + 4 * KVSLOT + (size_t)bg * SEQ * HD + tid * 8;
    u32x4 kA = *(const u32x4*)Ksel, vA = *(const u32x4*)(Ksel + KVSLOT);
    LAS unsigned* SELM = (LAS unsigned*)(lds + L_SELM);
    if (tid < 65) SELM[tid] = 0u;
#pragma unroll
    for (int i = 0; i < 2; ++i) { const int c = tid + 512 * i, row = c >> 3, ch = c & 7;
        *(LAS u32x4*)(lds + L_KV + row * ROWB + ch * 16) = *(const u32x4*)(KCMP + (size_t)bg * 8192 + c * 8);
        *(LAS u32x4*)(lds + L_KV + (128 + row) * ROWB + ch * 16) = *(const u32x4*)(VCMP + (size_t)bg * 8192 + c * 8); }
    __syncthreads();
    const int i16 = lane & 15, q4 = i16 >> 2, p4 = i16 & 3, blk = (lane >> 4) & 1;
    const int koff = r * ROWB + h * 16, voff = (4 * h + q4) * ROWB + blk * 32 + p4 * 8;
    f32x16 tot[2];
    {
        f32x16 st[4];
        const int tmaxw = t0 + 32 * th + 31, nmaxw = (tmaxw - 31) >> 4;
#pragma unroll
        for (int c = 0; c < 4; ++c) { if (32 * c <= nmaxw) qk_tile(st[c], lds + L_KV + (32 * c) * ROWB + koff, qf); else st[c] = f32x16{}; }
        const int nmax = ((t >= 31) ? ((t - 31) >> 4) : -1) - 4 * h;
        float mx = NEG;
#pragma unroll
        for (int c = 0; c < 4; ++c)
#pragma unroll
            for (int q = 0; q < 16; ++q) { const int n = 32 * c + crow(q, 0); if (n > nmax) st[c][q] = NEG; mx = fmaxf(mx, st[c][q]); }
        mx = fmaxf(mx, __shfl_xor(mx, 32));
        float sum = 0.f;
#pragma unroll
        for (int c = 0; c < 4; ++c)
#pragma unroll
            for (int q = 0; q < 16; ++q) { const int n = 32 * c + crow(q, 0); const float p = (n <= nmax && 32 * c <= nmaxw) ? __builtin_amdgcn_exp2f(st[c][q] - mx) : 0.f; st[c][q] = p; sum += p; }
        sum += __shfl_xor(sum, 32);
        const float inv = sum > 0.f ? 1.f / sum : 0.f;
#pragma unroll
        for (int c = 0; c < 4; ++c) st[c] = st[c] * inv;
        if (tb > 15) {
            LAS float* S4 = (LAS float*)(lds + L_S4) + (hh * 64 + tl) * 33; LAS float* LS = (LAS float*)(lds + L_LS) + (hh * 64 + tl) * 33;
#pragma unroll
            for (int c = 0; c < 4; ++c)
#pragma unroll
                for (int gq = 0; gq < 4; ++gq) { const int ch = 8 * c + 2 * gq + h;
                    S4[ch] = (st[c][4 * gq] + st[c][4 * gq + 1]) + (st[c][4 * gq + 2] + st[c][4 * gq + 3]);
                    if (ch < 31) LS[ch + 1] = st[c][4 * gq + 3]; else LS[0] = 0.f; }
        }
        f32x16 o[2]; o[0] = f32x16{}; o[1] = f32x16{};
#pragma unroll
        for (int c = 0; c < 4; ++c) if (32 * c <= nmaxw) pv_tile(o, st[c], lds + L_KV + (128 + 32 * c) * ROWB + voff);
        tot[0] = o[0] * g0; tot[1] = o[1] * g0;
    }
    __syncthreads();
    if (tb > 15) {
        const int tt = tid >> 3, jj = tid & 7;
        LAS const float* S4 = (LAS const float*)(lds + L_S4); LAS const float* LS = (LAS const float*)(lds + L_LS); LAS float* IMP = (LAS float*)(lds + L_IMP);
#pragma unroll
        for (int i = 0; i < 4; ++i) { const int j = jj + 8 * i; float v = 0.f;
#pragma unroll
            for (int q = 0; q < 4; ++q) v += S4[(q * 64 + tt) * 33 + j] + LS[(q * 64 + tt) * 33 + j];
            if (j == 0 || j == tb || j == tb - 1) v = 1e9f;
            if (j > tb) v = NEG;
            IMP[tt * 33 + j] = v; }
        __syncthreads();
        unsigned bits = 0u;
        float vv[4]; int rank[4];
#pragma unroll
        for (int i = 0; i < 4; ++i) { vv[i] = IMP[tt * 33 + jj + 8 * i]; rank[i] = 0; }
#pragma unroll 1
        for (int j2 = 0; j2 <= tb; ++j2) { const float v2 = IMP[tt * 33 + j2];
#pragma unroll
            for (int i = 0; i < 4; ++i) rank[i] += (v2 > vv[i] || (v2 == vv[i] && j2 < jj + 8 * i)) ? 1 : 0; }
#pragma unroll
        for (int i = 0; i < 4; ++i) { const int j = jj + 8 * i; if (rank[i] < 16 && j <= tb) bits |= 1u << j; }
        if (bits) { atomicOr((unsigned*)&SELM[tt], bits); atomicOr((unsigned*)&SELM[64], bits); }
        __syncthreads();
    }
    const unsigned allm = (2u << tb) - 1u;
    const unsigned selm = tb > 15 ? SELM[tl] : allm, umask = tb > 15 ? SELM[64] : allm;
    const int n_sel = __builtin_popcount(umask), jw0 = tb > 8 ? tb - 8 : 0, n_steps = n_sel + (tb - jw0 + 1);
    unsigned pf_rem = umask & ~1u; int pf_i = 1, jA = 0, jB = 0, j_cur;
    u32x4 kB, vB;
#define NSA_LOAD(KR, VR, JR) do { const bf16_t* kp_; if (pf_i < n_sel) { JR = __builtin_ctz(pf_rem); pf_rem &= pf_rem - 1u; kp_ = Ksel; } else { JR = jw0 + (pf_i - n_sel); JR = JR > tb ? tb : JR; kp_ = Kwin; } ++pf_i; \
        KR = *(const u32x4*)(kp_ + (size_t)JR * 64 * HD); VR = *(const u32x4*)(kp_ + KVSLOT + (size_t)JR * 64 * HD); } while (0)
#define NSA_STORE(buf, KR, VR) do { LAS char* d_ = lds + L_KV + (buf) * 2 * TILEB + (tid >> 3) * ROWB + (tid & 7) * 16; *(LAS u32x4*)d_ = KR; *(LAS u32x4*)(d_ + TILEB) = VR; } while (0)
    j_cur = 0; NSA_STORE(0, kA, vA);
    NSA_LOAD(kA, vA, jA);
    __syncthreads();
    const int tlh = tl - 4 * h;
    float l_run = 0.f; f32x16 acc[2]; acc[0] = f32x16{}; acc[1] = f32x16{};
    for (int i = 0; i < n_steps; i += 2) {
        NSA_LOAD(kB, vB, jB);
        nsa_step(lds, i, j_cur, n_sel, tb, selm, tlh, g1, koff, voff, qf, acc, tot, l_run);
        if (i + 1 < n_steps) NSA_STORE((i + 1) & 1, kA, vA);
        j_cur = jA;
        __syncthreads();
        if (i + 1 >= n_steps) break;
        NSA_LOAD(kA, vA, jA);
        nsa_step(lds, i + 1, j_cur, n_sel, tb, selm, tlh, g1, koff, voff, qf, acc, tot, l_run);
        if (i + 2 < n_steps) NSA_STORE((i + 2) & 1, kB, vB);
        j_cur = jB;
        __syncthreads();
    }
    {   const float lt = l_run + __shfl_xor(l_run, 32); const float sc = g2 / lt; tot[0] += acc[0] * sc; tot[1] += acc[1] * sc; }
    bf16_t* dst = OB + m * D + head * HD + 4 * h;
#pragma unroll
    for (int dt = 0; dt < 2; ++dt)
#pragma unroll
        for (int gq = 0; gq < 4; ++gq) { u32x2 w; w.x = pk2(tot[dt][4 * gq], tot[dt][4 * gq + 1]); w.y = pk2(tot[dt][4 * gq + 2], tot[dt][4 * gq + 3]);
            *(u32x2*)(dst + 32 * dt + 8 * gq) = w; }
#undef NSA_LOAD
#undef NSA_STORE
}
DI void nsa_phase(const Args& a, LAS char* lds) {
    const bf16_t* QB = (const bf16_t*)(a.ws + WS_QB); const float* GATE = (const float*)(a.ws + WS_GATE); const bf16_t* KV = (const bf16_t*)(a.ws + WS_KV);
    const bf16_t* KCMP = (const bf16_t*)(a.ws + WS_KCMP); const bf16_t* VCMP = (const bf16_t*)(a.ws + WS_VCMP); bf16_t* OB = (bf16_t*)(a.ws + WS_OB);
    const int Gn = gridDim.x, vcu = (Gn % 8 == 0) ? (blockIdx.x % 8) * (Gn / 8) + blockIdx.x / 8 : blockIdx.x;
    for (int u = vcu; u < 1024; u += Gn) {
        const int c = u & 255, rnd = u >> 8, bgi = c >> 3, s = c & 7;
        const int tb = rnd == 0 ? s : rnd == 1 ? 15 - s : rnd == 2 ? 16 + s : 31 - s;
        nsa_unit(lds, bgi >> 2, bgi & 3, tb, QB, GATE, KV, KCMP, VCMP, OB);
    }
}
}

#define XB_TMO      128
#define XB_XCNT(j)  (256  + 64 * (j))
#define XB_XSUB(j)  (1280 + 64 * (j))
#define XB_XGEN(j)  (2304 + 64 * (j))
#define XB_TOP      3328
#define XB_TOPGEN   3392
#define XCD_BAR_WORDS 3456
#define XB_SPIN_CAP (1u << 18)

__device__ __forceinline__ unsigned xb_ld(unsigned* p)              { return __hip_atomic_load(p, __ATOMIC_RELAXED, __HIP_MEMORY_SCOPE_AGENT); }
__device__ __forceinline__ unsigned xb_add(unsigned* p, unsigned v) { return __hip_atomic_fetch_add(p, v, __ATOMIC_RELAXED, __HIP_MEMORY_SCOPE_AGENT); }
__device__ __forceinline__ unsigned xb_xcc_id() { return (unsigned)__builtin_amdgcn_s_getreg((3 << 11) | 20) & 0xFu; }
#define XB_SPIN(cond, bar) do { unsigned _sp = 0; while (cond) { __builtin_amdgcn_s_sleep(1); \
    if ((++_sp & 255u) == 0u) { if (xb_ld(&(bar)[XB_TMO])) break; if (_sp > XB_SPIN_CAP) { atomicAdd(&(bar)[XB_TMO], 1u); break; } } } } while (0)

struct XcdBarrier {
    unsigned* bar; unsigned x;
    volatile LAS unsigned* st;
};

__device__ __forceinline__ XcdBarrier xcd_barrier_post(unsigned* bar, volatile LAS unsigned* st) {
    XcdBarrier b; b.bar = bar; b.x = xb_xcc_id(); b.st = st;
    if (threadIdx.x == 0) (void)xb_add(&bar[XB_XCNT(b.x)], 1u);
    return b;
}
__device__ __forceinline__ void xcd_barrier_complete(unsigned* bar, unsigned x, unsigned& nloc, unsigned& nx) {
    const unsigned G = gridDim.x * gridDim.y * gridDim.z;
    unsigned sum, cnt, mine, sp = 0u;
    for (;;) {
        sum = 0u; cnt = 0u; mine = 0u;
#pragma unroll
        for (unsigned j = 0; j < 16; ++j) { const unsigned c = xb_ld(&bar[XB_XCNT(j)]); sum += c; cnt += (c > 0u) ? 1u : 0u; mine = (j == x) ? c : mine; }
        if (sum == G) break;
        __builtin_amdgcn_s_sleep(1);
        if ((++sp & 255u) == 0u) { if (xb_ld(&bar[XB_TMO])) break; if (sp > XB_SPIN_CAP) { atomicAdd(&bar[XB_TMO], 1u); break; } }
    }
    nloc = mine > 0u ? mine : 1u; nx = cnt > 0u ? cnt : 1u;
}

__device__ __forceinline__ void xcd_barrier(const XcdBarrier& b) {
    asm volatile("s_waitcnt vmcnt(0)" ::: "memory");
    __syncthreads();
    if (threadIdx.x == 0) {
        unsigned* bar = b.bar;
        __builtin_amdgcn_s_waitcnt(0);
        unsigned nloc = b.st[0], nx = b.st[1];
        if (nloc == 0u) { xcd_barrier_complete(bar, b.x, nloc, nx); b.st[0] = nloc; b.st[1] = nx; }
        const unsigned old = xb_add(&bar[XB_XSUB(b.x)], 1u);
        const unsigned gen = old / nloc;
        if (old + 1u == (gen + 1u) * nloc) {
            __builtin_amdgcn_fence(__ATOMIC_RELEASE, "agent");
            asm volatile("s_waitcnt vmcnt(0)" ::: "memory");
            const unsigned og = xb_add(&bar[XB_TOP], 1u);
            const unsigned tg = og / nx;
            if (og + 1u == (tg + 1u) * nx) xb_add(&bar[XB_TOPGEN], 1u);
            else XB_SPIN(xb_ld(&bar[XB_TOPGEN]) == tg, bar);
            __builtin_amdgcn_fence(__ATOMIC_ACQUIRE, "agent");
            xb_add(&bar[XB_XGEN(b.x)], 1u);
            asm volatile("s_waitcnt vmcnt(0)" ::: "memory");
        } else {
            XB_SPIN(xb_ld(&bar[XB_XGEN(b.x)]) == gen, bar);
            __builtin_amdgcn_fence(__ATOMIC_ACQUIRE, "agent");
            asm volatile("s_waitcnt vmcnt(0)" ::: "memory");
        }
    }
    __syncthreads();
}


__device__ __forceinline__ void xcc_barrier_light(const XcdBarrier& b) {
    asm volatile("s_waitcnt vmcnt(0)" ::: "memory");
    __syncthreads();
    if (threadIdx.x == 0) {
        unsigned* bar = b.bar;
        __builtin_amdgcn_s_waitcnt(0);
        const unsigned nloc = b.st[0];
        const unsigned old = xb_add(&bar[XB_XSUB(b.x)], 1u);
        const unsigned gen = old / nloc;
        if (old + 1u == (gen + 1u) * nloc) xb_add(&bar[XB_XGEN(b.x)], 1u);
        else { unsigned sp_ = 0u; while (xb_ld(&bar[XB_XGEN(b.x)]) == gen) { if (++sp_ > (1u << 22)) { atomicAdd(&bar[XB_TMO], 1u); break; } } }
        __builtin_amdgcn_fence(__ATOMIC_ACQUIRE, "agent");
        asm volatile("s_waitcnt vmcnt(0)" ::: "memory");
    }
    __syncthreads();
}

__global__ void __launch_bounds__(512, 2) yoco_fwd(Args a) {
    extern __shared__ __attribute__((aligned(16))) unsigned char lds_raw[];
    LAS unsigned char* lds = (LAS unsigned char*)lds_raw;
    cg::grid_group grid = cg::this_grid();
    unsigned char* ws = a.ws;
    volatile LAS unsigned* bst = (volatile LAS unsigned*)(lds + 131072 + 1024);
    if (threadIdx.x < 2) bst[threadIdx.x] = 0u;
    __syncthreads();
    XcdBarrier xbar = xcd_barrier_post((unsigned*)ws, bst);
    unsigned* misplaced = (unsigned*)ws + 8192;
    if (threadIdx.x == 0) __hip_atomic_fetch_or(misplaced + 64 * (blockIdx.x % 8u), 1u << xbar.x, __ATOMIC_RELAXED, __HIP_MEMORY_SCOPE_AGENT);
    bool light_ok = false;
    const int lo = a.ph_lo, hi = a.ph_hi, G = gridDim.x, c0 = blockIdx.x;
#define IN(k) (lo <= (k) && (k) < hi)
#define SEAM(k) do { if (IN(k) && IN((k) + 1)) { \
        const bool loc_ = ((k) == 2 || (k) == 3 || (k) == 4 || (k) == 5 || (k) == 7 || (k) == 8 || (k) == 9 || (k) == 12 || (k) == 13 || (k) == 14);     \
        if (loc_ && light_ok) xcc_barrier_light(xbar); else xcd_barrier(xbar); \
        if ((k) == 0) { unsigned all_ = 0u; bool one_ = true; for (int r_ = 0; r_ < 8; ++r_) { const unsigned m_ = __hip_atomic_load(misplaced + 64 * r_, __ATOMIC_RELAXED, __HIP_MEMORY_SCOPE_AGENT); one_ = one_ && (__builtin_popcount(m_) == 1) && ((all_ & m_) == 0u); all_ |= m_; } \
            light_ok = (G % 8 == 0) && one_; } } } while (0)
    if (hi > NPHASE) grid.sync();
    bf16_t* HB = (bf16_t*)(ws + WS_HB); float* SS = (float*)(ws + WS_SS); bf16_t* ACT = (bf16_t*)(ws + WS_ACT);
    const bf16_t* WGU = (const bf16_t*)(ws + WS_WGU); const bf16_t* WD = (const bf16_t*)(ws + WS_WD);
#define GEMM(EpiT, E, Aptr, Bptr, NN, KK, LDA, cc) do { pg8::Gemm g_{(Aptr), (Bptr), M, (NN), (KK), (LDA)}; pg8::StaticOrder S_; S_.init(M, (NN), G, (cc)); \
        pg8::gemm_phase<EpiT, pg8::StaticOrder, true, true>(lds, g_, S_, (E)); } while (0)
    if (IN(0)) { prologue(a, lds); } SEAM(0);
    const int wv = __builtin_amdgcn_readfirstlane(threadIdx.x >> 6);
    const int gu_rem = (64 * 22) % G;
#define IDLE_CONVERT(first, last, nbusy) do { if (c0 >= (nbusy)) convert_items(a, lds, (first), (last), (c0 - (nbusy)) * 8 + wv, (G - (nbusy)) * 8); } while (0)
    if (IN(1)) { EpiGU E{SS, ACT}; GEMM(EpiGU, E, HB, WGU, 2 * DFF, D, D, c0); IDLE_CONVERT(cv::E0, cv::E1, gu_rem); } SEAM(1);
    if (IN(2)) { typedef EpiRes<false, false> EpiT; EpiT E{nullptr, nullptr, HB, SS, 0.5f}; GEMM(EpiT, E, ACT, WD, D, DFF, DFF, c0); } SEAM(2);
    if (IN(3)) { EpiConvIn E{SS, (bf16_t*)(ws + WS_VB), (bf16_t*)(ws + WS_BG)}; GEMM(EpiConvIn, E, HB, (const bf16_t*)(ws + WS_WCIN), 3 * D, D, D, c0); } SEAM(3);
    if (IN(4)) { conv_phase(a); } SEAM(4);
    if (IN(5)) { typedef EpiRes<false, false> EpiT; EpiT E{nullptr, nullptr, HB, SS, 1.0f}; GEMM(EpiT, E, (const bf16_t*)(ws + WS_Y), (const bf16_t*)(ws + WS_WCOUT), D, D, D, c0); } SEAM(5);
    if (IN(6)) { EpiGU E{SS, ACT}; GEMM(EpiGU, E, HB, WGU + WGU_ELEMS, 2 * DFF, D, D, c0); IDLE_CONVERT(cv::E1, cv::E2, gu_rem); } SEAM(6);
    if (IN(7)) { typedef EpiRes<false, false> EpiT; EpiT E{nullptr, nullptr, HB, SS, 0.5f}; GEMM(EpiT, E, ACT, WD + WD_ELEMS, D, DFF, DFF, c0); } SEAM(7);
    if (IN(8)) { { EpiKV E{SS, (bf16_t*)(ws + WS_KV), a.k_norm}; GEMM(EpiKV, E, HB, (const bf16_t*)(ws + WS_WKV), NKV, D, D, c0); }
                 { EpiGU E{SS, ACT}; GEMM(EpiGU, E, HB, WGU + 2 * WGU_ELEMS, 2 * DFF, D, D, (c0 + G / 2) % G); } } SEAM(8);
    if (IN(9)) { typedef EpiRes<false, false> EpiT; EpiT E{nullptr, nullptr, HB, SS, 0.5f}; GEMM(EpiT, E, ACT, WD + 2 * WD_ELEMS, D, DFF, DFF, c0); } SEAM(9);
    if (IN(10)) {
        const bool sep = (G >= 128), cmpblk = sep && c0 >= 64 && c0 < 96;
        const int Gq = sep ? G - 32 : G, wq = sep ? (c0 < 64 ? c0 : c0 - 32) : c0;
        if (!cmpblk) { EpiQG E{SS, (bf16_t*)(ws + WS_QB), (float*)(ws + WS_GATE), a.q_norm};
            pg8::Gemm g_{HB, (const bf16_t*)(ws + WS_WQG), M, NQGP, D, D}; pg8::StaticOrder S_; S_.init(M, NQGP, Gq, wq);
            pg8::gemm_phase<EpiQG, pg8::StaticOrder, true, true>(lds, g_, S_, E); }
        if (!sep || cmpblk) {
            for (int slot = 0; slot < 2; ++slot) { EpiHid E{(const float*)(ws + WS_BIASC) + slot * 256, (bf16_t*)(ws + WS_HID) + (size_t)slot * 4096 * 256};
                pg8::Gemm g_{(const bf16_t*)(ws + WS_KV) + (size_t)slot * KVSLOT, (const bf16_t*)(ws + WS_WC1) + (size_t)slot * 256 * 2048, 4096, 256, 2048, 1024};
                pg8::StaticOrder S_; S_.init(4096, 256, G, (c0 + G - 64 - 16 * slot + G) % G);
                pg8::gemm_phase<EpiHid, pg8::StaticOrder, true, true>(lds, g_, S_, E);
                for (int L = (c0 + G - 64 - 16 * slot + G) % G; L < 16; L += G) { const int pmL = (L % 8) * 2 + L / 8; __syncthreads(); cmp2_unit(a, slot, pmL * 8 + wv); } } }
        const int nb2 = (64 * 5) % Gq;
        if (!cmpblk && wq >= nb2) convert_items(a, lds, cv::E2, cv::E4, (wq - nb2) * 8 + wv, (Gq - nb2) * 8);
    } SEAM(10);
    if (IN(12)) { nsa::nsa_phase(a, (LAS char*)lds); } SEAM(12);
    if (IN(13)) { typedef EpiRes<false, false> EpiT; EpiT E{nullptr, nullptr, HB, SS, 1.0f}; GEMM(EpiT, E, (const bf16_t*)(ws + WS_OB), (const bf16_t*)(ws + WS_WO), D, D, D, c0); } SEAM(13);
    if (IN(14)) { EpiGU E{SS, ACT}; GEMM(EpiGU, E, HB, WGU + 3 * WGU_ELEMS, 2 * DFF, D, D, c0); } SEAM(14);
    if (IN(15)) { typedef EpiRes<false, true> EpiT; EpiT E{nullptr, a.out, HB, nullptr, 0.5f}; GEMM(EpiT, E, ACT, WD + 3 * WD_ELEMS, D, DFF, DFF, c0); }
#undef IN
#undef SEAM
#undef GEMM
}

#ifndef PER_PHASE_LAUNCH
#define PER_PHASE_LAUNCH 0
#endif
extern "C" void kernel_launch(void* const* d_in, const int* in_sizes, int n_in, void* d_out, int out_size, void* d_ws, size_t ws_size, hipStream_t stream) {
    static int grid = 0;
    if (grid == 0) {
        if (n_in != 18 || in_sizes[0] != M * D || out_size != M * D || ws_size < WS_END) { fprintf(stderr, "kernel_launch: unexpected problem (n_in %d, in0 %d, out %d, ws %zu)\n", n_in, n_in > 0 ? in_sizes[0] : -1, out_size, ws_size); grid = -1; return; }
        int dev = 0, cus = 0, per_cu = 0;
        if (hipGetDevice(&dev) != hipSuccess || hipDeviceGetAttribute(&cus, hipDeviceAttributeMultiprocessorCount, dev) != hipSuccess) { grid = -1; return; }
        if (hipFuncSetAttribute((const void*)yoco_fwd, hipFuncAttributeMaxDynamicSharedMemorySize, LDS_BYTES) != hipSuccess) { fprintf(stderr, "kernel_launch: hipFuncSetAttribute failed\n"); grid = -1; return; }
        if (hipOccupancyMaxActiveBlocksPerMultiprocessor(&per_cu, (const void*)yoco_fwd, 512, LDS_BYTES) != hipSuccess || per_cu < 1) { fprintf(stderr, "kernel_launch: occupancy query says %d\n", per_cu); per_cu = 1; }
        (void)hipGetLastError();
        grid = cus;
    }
    if (grid < 0) return;
    Args a{};
    const float** ap = (const float**)&a;
    for (int i = 0; i < 18; ++i) ap[i] = (const float*)d_in[i];
    a.out = (float*)d_out; a.ws = (unsigned char*)d_ws;
#if PER_PHASE_LAUNCH
    for (int p = 0; p < NPHASE; ++p) { a.ph_lo = p; a.ph_hi = p + 1; hipLaunchKernelGGL(yoco_fwd, dim3(grid), dim3(512), LDS_BYTES, stream, a); }
#else
    a.ph_lo = 0; a.ph_hi = NPHASE;
    if (hipMemsetAsync(d_ws, 0, 65536, stream) != hipSuccess) { fprintf(stderr, "kernel_launch: memset failed\n"); return; }
    void* args[] = {&a};
    hipError_t e = hipLaunchCooperativeKernel((const void*)yoco_fwd, dim3(grid), dim3(512), args, LDS_BYTES, stream);
    if (e != hipSuccess) fprintf(stderr, "kernel_launch: cooperative launch failed: %s (grid %d)\n", hipGetErrorString(e), grid);
#endif
}
```

```cpp
#include <hip/hip_runtime.h>
#include <hip/hip_cooperative_groups.h>
#include <cstdio>
#include <cstdint>
namespace cg = cooperative_groups;

#define DI __device__ __forceinline__
#define LAS __attribute__((address_space(3)))
typedef unsigned short bf16_t;
typedef short bf16x8 __attribute__((ext_vector_type(8)));
typedef short s16x4 __attribute__((ext_vector_type(4)));
typedef float f32x2 __attribute__((ext_vector_type(2)));
typedef float f32x4 __attribute__((ext_vector_type(4)));
typedef float f32x16 __attribute__((ext_vector_type(16)));
typedef unsigned u32x2 __attribute__((ext_vector_type(2)));
typedef unsigned u32x4 __attribute__((ext_vector_type(4)));
typedef __bf16 bf16x2_t __attribute__((ext_vector_type(2)));
typedef short v4i16_t __attribute__((ext_vector_type(4)));

DI unsigned pk2(float lo, float hi) { f32x2 v = {lo, hi}; bf16x2_t b = __builtin_convertvector(v, bf16x2_t); return __builtin_bit_cast(unsigned, b); }
DI float bf2f(unsigned short u) { return __uint_as_float((unsigned)u << 16); }
DI float bflo(unsigned w) { return __uint_as_float(w << 16); }
DI float bfhi(unsigned w) { return __uint_as_float(w & 0xffff0000u); }

namespace pg8 {
#define PG8_LAS __attribute__((address_space(3)))
constexpr int BM = 256, BK = 64, HALF = 128, HTB = HALF * BK * 2, STAGE_BYTES = 8 * HTB, NXCD = 8, WGM = 8;
__host__ __device__ __forceinline__ int lds_byte(int r, int c) { const int st = (r >> 4) * 2 + (c >> 5), rr = r & 15, cc = c & 31, ob = rr * 64 + cc * 2; return st * 1024 + (ob ^ (((ob >> 9) & 1) << 5)); }
__host__ __device__ __forceinline__ void stage_rc(int b, int& R, int& C) { const int st = b / 1024, sb = b % 1024, swz = sb ^ (((sb >> 9) & 1) << 5); R = (st >> 1) * 16 + swz / 64; C = (st & 1) * 32 + (swz % 64) / 2; }
__host__ __device__ __forceinline__ int perm32(int rho) { const int n = rho >> 4, i = rho & 15; return 8 * (i >> 2) + 4 * n + (i & 3); }
struct Unit { int pm, pn; };
struct Gemm { const bf16_t* A; const bf16_t* Bt; int M, N, K, lda; };
struct StaticOrder {
    int nM, nN, nwg, G, c;
    __host__ __device__ void init(int M, int N, int G_, int c_) { nM = M / BM; nN = N / BM; nwg = nM * nN; G = G_; c = c_; }
    __host__ __device__ bool next(int i, Unit& u) const {
        const long L = (long)i * G + c; if (L >= nwg) return false;
        int wgid = (int)L; { const int q = nwg / NXCD, r = nwg % NXCD, xcd = wgid % NXCD, off = wgid / NXCD; wgid = (xcd < r ? xcd * (q + 1) : r * (q + 1) + (xcd - r) * q) + off; }
        const int nig = WGM * nN, gid = wgid / nig, fm = gid * WGM, gsz = (nM - fm) < WGM ? (nM - fm) : WGM;
        u.pm = fm + ((wgid % nig) % gsz); u.pn = (wgid % nig) / gsz; return true;
    }
    __device__ __forceinline__ void a_ready(const Unit&) const {}
    __device__ __forceinline__ void done(const Unit&) const {}
};
template <class Epi, class Sched, bool ALIGN_EPI = false, bool SP2 = false>
__device__ __forceinline__ void gemm_phase(PG8_LAS unsigned char* lds, const Gemm g, const Sched& S, const Epi& E) {
    const int tid = threadIdx.x, wid = __builtin_amdgcn_readfirstlane(tid >> 6), lane = tid & 63, wr = wid >> 2, wc = wid & 3, fr = lane & 15, fq = lane >> 4;
    const int K = g.K, nt = K / BK;
    unsigned voffA[2], voffB[2];
#pragma unroll
    for (int i = 0; i < 2; ++i) { int R, C; stage_rc(tid * 16 + i * 8192, R, C); const int Rb = Epi::PERM ? ((R & ~31) + perm32(R & 31)) : R;
        voffA[i] = (unsigned)(R * g.lda + C) * 2u; voffB[i] = (unsigned)(Rb * K + C) * 2u; }
    const size_t kstep = (size_t)(BK * 2);
    const size_t hstepA = (size_t)HALF * g.lda * 2, hstepB = (size_t)HALF * K * 2;
    const size_t tstepA = 2 * hstepA, tstepB = 2 * hstepB;
    const unsigned ldsw = (unsigned)wid * 1024u;
    const int aoff = lds_byte(wr * 64 + fr, fq * 8), boff = lds_byte(wc * 32 + fr, fq * 8);
#define PG8_SA(b, h) (((b) * 2 + (h)) * HTB)
#define PG8_SB(b, h) ((4 + (b) * 2 + (h)) * HTB)
#define PG8_STAGE(bufoff, gbase, voff) do { _Pragma("unroll") for (int _i = 0; _i < 2; ++_i) \
        __builtin_amdgcn_global_load_lds((const unsigned*)((const char*)(gbase) + (voff)[_i]), (PG8_LAS unsigned*)(lds + (bufoff) + ldsw + _i * 8192), 16, 0, 0); } while (0)
#define PG8_LDA(dst, b, h) do { _Pragma("unroll") for (int m = 0; m < 4; ++m) _Pragma("unroll") for (int k = 0; k < 2; ++k) dst[m][k] = *(const PG8_LAS bf16x8*)(lds + PG8_SA(b, h) + aoff + m * 2048 + k * 1024); } while (0)
#define PG8_LDB(dst, b, h) do { _Pragma("unroll") for (int n = 0; n < 2; ++n) _Pragma("unroll") for (int k = 0; k < 2; ++k) dst[n][k] = *(const PG8_LAS bf16x8*)(lds + PG8_SB(b, h) + boff + n * 2048 + k * 1024); } while (0)
#define PG8_MMA(ai, bj, At, Bt) do { __builtin_amdgcn_s_setprio(1); _Pragma("unroll") for (int m = 0; m < 4; ++m) _Pragma("unroll") for (int n = 0; n < 2; ++n) _Pragma("unroll") for (int k = 0; k < 2; ++k) \
        acc[ai][bj][m][n] = __builtin_amdgcn_mfma_f32_16x16x32_bf16(Bt[n][k], At[m][k], acc[ai][bj][m][n], 0, 0, 0); __builtin_amdgcn_s_setprio(0); } while (0)
#define PG8_WAIT_V(n) asm volatile("s_waitcnt vmcnt(" #n ")" ::: "memory")
#define PG8_WAIT_L(n) asm volatile("s_waitcnt lgkmcnt(" #n ")" ::: "memory")
#define PG8_BAR __builtin_amdgcn_s_barrier()
#define PG8_SCHED __builtin_amdgcn_sched_barrier(0)
    Unit cur, nxt; int ui = 0;
    if (!S.next(0, cur)) return;
    f32x4 acc[2][2][4][2];
#pragma unroll
    for (int a = 0; a < 2; ++a)
#pragma unroll
        for (int b = 0; b < 2; ++b)
#pragma unroll
            for (int m = 0; m < 4; ++m)
#pragma unroll
                for (int n = 0; n < 2; ++n) acc[a][b][m][n] = (f32x4){0.f, 0.f, 0.f, 0.f};
    bf16x8 At[4][2], B0[2][2], B1[2][2];
    const char* cA = (const char*)g.A + (size_t)cur.pm * tstepA; const char* cB = (const char*)g.Bt + (size_t)cur.pn * tstepB;
    S.a_ready(cur);
    if constexpr (SP2) {
        PG8_STAGE(PG8_SB(0, 0), cB, voffB); PG8_STAGE(PG8_SB(0, 1), cB + hstepB, voffB); PG8_STAGE(PG8_SA(0, 0), cA, voffA); PG8_STAGE(PG8_SA(0, 1), cA + hstepA, voffA);
        if (wr == 1) PG8_BAR;
        PG8_WAIT_V(2); PG8_BAR;
        PG8_STAGE(PG8_SB(1, 0), cB + kstep, voffB); PG8_STAGE(PG8_SA(1, 0), cA + kstep, voffA); PG8_STAGE(PG8_SB(1, 1), cB + hstepB + kstep, voffB);
        PG8_WAIT_V(6); PG8_BAR;
    } else {
        PG8_STAGE(PG8_SB(0, 0), cB, voffB); PG8_STAGE(PG8_SA(0, 0), cA, voffA); PG8_STAGE(PG8_SB(0, 1), cB + hstepB, voffB); PG8_STAGE(PG8_SA(0, 1), cA + hstepA, voffA);
        if (wr == 1) PG8_BAR;
        PG8_WAIT_V(4); PG8_BAR;
        PG8_STAGE(PG8_SB(1, 0), cB + kstep, voffB); PG8_STAGE(PG8_SA(1, 0), cA + kstep, voffA); PG8_STAGE(PG8_SB(1, 1), cB + hstepB + kstep, voffB);
        PG8_WAIT_V(6); PG8_BAR;
    }
    for (;;) {
        const bool has_next = S.next(ui + 1, nxt);
        const char* nA = has_next ? (const char*)g.A + (size_t)nxt.pm * tstepA : cA; const char* nB = has_next ? (const char*)g.Bt + (size_t)nxt.pn * tstepB : cB;
        for (int t = 0; t < nt; t += 2) {
            const bool last = (t == nt - 2);
            const char* a1 = cA + (size_t)(t + 1) * kstep;
            const char* a2 = last ? nA : cA + (size_t)(t + 2) * kstep; const char* b2 = last ? nB : cB + (size_t)(t + 2) * kstep;
            const char* a3 = a2 + kstep; const char* b3 = b2 + kstep;
            if (last && has_next) S.a_ready(nxt);
            if constexpr (SP2) {
            PG8_LDB(B0, 0, 0); PG8_LDB(B1, 0, 1); PG8_SCHED; PG8_LDA(At, 0, 0); PG8_STAGE(PG8_SA(1, 1), a1 + hstepA, voffA);
            PG8_WAIT_V(8); PG8_WAIT_L(0); PG8_BAR; PG8_MMA(0, 0, At, B0); PG8_MMA(0, 1, At, B1); PG8_BAR; PG8_SCHED;
            PG8_LDA(At, 0, 1); PG8_STAGE(PG8_SB(0, 0), b2, voffB); PG8_STAGE(PG8_SB(0, 1), b2 + hstepB, voffB); PG8_STAGE(PG8_SA(0, 0), a2, voffA);
            PG8_WAIT_V(8); PG8_WAIT_L(0); PG8_BAR; PG8_MMA(1, 0, At, B0); PG8_MMA(1, 1, At, B1); PG8_BAR; PG8_SCHED;
            PG8_LDB(B0, 1, 0); PG8_LDB(B1, 1, 1); PG8_SCHED; PG8_LDA(At, 1, 0); PG8_STAGE(PG8_SA(0, 1), a2 + hstepA, voffA);
            PG8_WAIT_V(8); PG8_WAIT_L(0); PG8_BAR; PG8_MMA(0, 0, At, B0); PG8_MMA(0, 1, At, B1); PG8_BAR; PG8_SCHED;
            PG8_LDA(At, 1, 1); PG8_STAGE(PG8_SB(1, 0), b3, voffB); PG8_STAGE(PG8_SB(1, 1), b3 + hstepB, voffB); PG8_STAGE(PG8_SA(1, 0), a3, voffA);
            PG8_WAIT_V(8); PG8_WAIT_L(0); PG8_BAR; PG8_MMA(1, 0, At, B0); PG8_MMA(1, 1, At, B1); PG8_BAR; PG8_SCHED;
            } else {
            PG8_LDB(B0, 0, 0); PG8_SCHED; PG8_LDA(At, 0, 0); PG8_STAGE(PG8_SA(1, 1), a1 + hstepA, voffA);
            PG8_WAIT_L(8); PG8_BAR; PG8_WAIT_L(0); PG8_MMA(0, 0, At, B0); PG8_BAR; PG8_SCHED;
            PG8_LDB(B1, 0, 1); PG8_STAGE(PG8_SB(0, 0), b2, voffB);
            PG8_BAR; PG8_WAIT_L(0); PG8_MMA(0, 1, At, B1); PG8_BAR;
            PG8_LDA(At, 0, 1); PG8_STAGE(PG8_SA(0, 0), a2, voffA);
            PG8_BAR; PG8_WAIT_L(0); PG8_MMA(1, 0, At, B0); PG8_BAR; PG8_SCHED;
            PG8_STAGE(PG8_SB(0, 1), b2 + hstepB, voffB);
            PG8_WAIT_V(6); PG8_BAR; PG8_MMA(1, 1, At, B1); PG8_BAR;
            PG8_LDB(B0, 1, 0); PG8_SCHED; PG8_LDA(At, 1, 0); PG8_STAGE(PG8_SA(0, 1), a2 + hstepA, voffA);
            PG8_WAIT_L(8); PG8_BAR; PG8_WAIT_L(0); PG8_MMA(0, 0, At, B0); PG8_BAR; PG8_SCHED;
            PG8_LDB(B1, 1, 1); PG8_STAGE(PG8_SB(1, 0), b3, voffB);
            PG8_BAR; PG8_WAIT_L(0); PG8_MMA(0, 1, At, B1); PG8_BAR;
            PG8_LDA(At, 1, 1); PG8_STAGE(PG8_SA(1, 0), a3, voffA);
            PG8_BAR; PG8_WAIT_L(0); PG8_MMA(1, 0, At, B0); PG8_BAR; PG8_SCHED;
            PG8_STAGE(PG8_SB(1, 1), b3 + hstepB, voffB);
            PG8_WAIT_V(6); PG8_BAR; PG8_MMA(1, 1, At, B1); PG8_BAR;
            }
        }
        if constexpr (ALIGN_EPI) { if (wr == 0) PG8_BAR; }
        if constexpr (!Epi::AFTER_DRAIN) { E(acc, cur, wr, wc, fr, fq); S.done(cur); }
        if (!has_next) break;
#pragma unroll
        for (int a = 0; a < 2; ++a)
#pragma unroll
            for (int b = 0; b < 2; ++b)
#pragma unroll
                for (int m = 0; m < 4; ++m)
#pragma unroll
                    for (int n = 0; n < 2; ++n) acc[a][b][m][n] = (f32x4){0.f, 0.f, 0.f, 0.f};
        cur = nxt; cA = nA; cB = nB; ++ui;
        if constexpr (ALIGN_EPI) { if (wr == 1) PG8_BAR; }
    }
    PG8_WAIT_V(0);
    if constexpr (!ALIGN_EPI) { if (wr == 0) PG8_BAR; }
    PG8_BAR;
    if constexpr (Epi::AFTER_DRAIN) { E.fused(acc, cur, wr, wc, fr, fq, lds, wid, lane); S.done(cur); }
#undef PG8_SA
#undef PG8_SB
#undef PG8_STAGE
#undef PG8_LDA
#undef PG8_LDB
#undef PG8_MMA
#undef PG8_WAIT_V
#undef PG8_WAIT_L
#undef PG8_BAR
#undef PG8_SCHED
}
}

constexpr int D = 1024, BATCH = 8, SEQ = 2048, M = BATCH * SEQ, DFF = 2816, NH = 16, HD = 64, NG = 4;
constexpr int NQG = 1072, NQGP = 1280, NKV = 1536, NGATE = 48;
constexpr float EPS = 1e-6f;
constexpr float QSCALE = 0.125f * 1.4426950408889634f;
constexpr float NEG = -1e30f;
constexpr size_t MiB = 1u << 20;
constexpr size_t WS_WGU = 1 * MiB, WS_WD = 45 * MiB, WS_WCIN = 67 * MiB, WS_WCOUT = 73 * MiB, WS_WKV = 75 * MiB, WS_WQG = 78 * MiB, WS_WO = 81 * MiB,
                 WS_WC1 = 83 * MiB, WS_WC2T = 85 * MiB, WS_BIASC = 85 * MiB + 256 * 1024, WS_SS = 86 * MiB, WS_HB = 87 * MiB, WS_H = 119 * MiB,
                 WS_ACT = 183 * MiB, WS_KV = 271 * MiB, WS_HID = 320 * MiB, WS_KCMP = 324 * MiB, WS_VCMP = 324 * MiB + 512 * 1024, WS_END = 325 * MiB;
constexpr size_t WS_VB = WS_ACT, WS_BG = WS_ACT + 32 * MiB, WS_Y = WS_KV;
constexpr size_t WS_QB = WS_ACT, WS_OB = WS_ACT + 32 * MiB, WS_GATE = WS_ACT + 64 * MiB;
constexpr size_t WGU_ELEMS = (size_t)2 * DFF * D, WD_ELEMS = (size_t)D * DFF, KVSLOT = (size_t)M * 256;
constexpr int LDS_BYTES = 147456;
constexpr int NPHASE = 16;

struct Args {
    const float *x, *ffn_norm, *w_gu, *w_down, *mix_norm, *conv_w_in, *conv_w, *conv_w_out, *kv_norm, *kv_w, *cmp_pos, *cmp_w1, *cmp_b1, *cmp_w2, *k_norm, *w_qg, *q_norm, *w_o;
    float* out; unsigned char* ws; int ph_lo, ph_hi;
};

DI float rstd_row(const float* SS, int row, int fq) {
    const f32x4 v = *(const f32x4*)(SS + (size_t)row * 16 + 4 * fq);
    float s = (v.x + v.y) + (v.z + v.w); s += __shfl_xor(s, 16); s += __shfl_xor(s, 32);
    return rsqrtf(s * (1.f / D) + EPS);
}
DI float sigm(float a) { return __builtin_amdgcn_rcpf(1.f + __expf(-a)); }
DI void rstd_rows(float (&rs)[2][4], const float* SS, int row0, int fq) {
    f32x4 v[2][4];
#pragma unroll
    for (int ai = 0; ai < 2; ++ai)
#pragma unroll
        for (int m = 0; m < 4; ++m) v[ai][m] = *(const f32x4*)(SS + (size_t)(row0 + ai * 128 + m * 16) * 16 + 4 * fq);
#pragma unroll
    for (int ai = 0; ai < 2; ++ai)
#pragma unroll
        for (int m = 0; m < 4; ++m) { float t = (v[ai][m].x + v[ai][m].y) + (v[ai][m].z + v[ai][m].w); t += __shfl_xor(t, 16); t += __shfl_xor(t, 32); rs[ai][m] = rsqrtf(t * (1.f / D) + EPS); }
}

struct EpiGU {
    static constexpr bool PERM = true, AFTER_DRAIN = false; const float* SS; bf16_t* ACT;
    DI void operator()(const f32x4 (&acc)[2][2][4][2], const pg8::Unit& u, int wr, int wc, int fr, int fq) const {
        const int row0 = u.pm * 256 + wr * 64 + fr; float rs[2][4]; rstd_rows(rs, SS, row0, fq);
        bf16_t* dst = ACT + (size_t)row0 * DFF + u.pn * 128 + wc * 32 + 8 * fq;
#pragma unroll
        for (int ai = 0; ai < 2; ++ai)
#pragma unroll
            for (int m = 0; m < 4; ++m) { const float r1 = rs[ai][m], r2 = r1 * r1, k1 = -1.4426950408889634f * r1; float o[8];
#pragma unroll
                for (int n = 0; n < 2; ++n)
#pragma unroll
                    for (int i = 0; i < 4; ++i) { const float ga = acc[ai][0][m][n][i], up = acc[ai][1][m][n][i];
                        o[4 * n + i] = (ga * up) * (r2 * __builtin_amdgcn_rcpf(1.f + __builtin_amdgcn_exp2f(ga * k1))); }
                u32x4 w; w.x = pk2(o[0], o[1]); w.y = pk2(o[2], o[3]); w.z = pk2(o[4], o[5]); w.w = pk2(o[6], o[7]);
                *(u32x4*)(dst + (size_t)(ai * 128 + m * 16) * DFF) = w; }
    }
};
template <bool SRC32, bool DST32> struct EpiRes {
    static constexpr bool PERM = true, AFTER_DRAIN = false; const float* src32; float* dst32; bf16_t* HB; float* SS; float scale;
    DI void operator()(const f32x4 (&acc)[2][2][4][2], const pg8::Unit& u, int wr, int wc, int fr, int fq) const {
#pragma unroll
        for (int ai = 0; ai < 2; ++ai) {
            const int row0 = u.pm * 256 + ai * 128 + wr * 64 + fr; const size_t off0 = (size_t)row0 * D + u.pn * 256 + wc * 32 + 8 * fq;
            f32x4 hv[4][2][2];
            if constexpr (SRC32) {
#pragma unroll
                for (int m = 0; m < 4; ++m)
#pragma unroll
                    for (int bj = 0; bj < 2; ++bj) { hv[m][bj][0] = *(const f32x4*)(src32 + off0 + (size_t)m * 16 * D + bj * 128); hv[m][bj][1] = *(const f32x4*)(src32 + off0 + (size_t)m * 16 * D + bj * 128 + 4); }
            } else {
                u32x4 hw[4][2];
#pragma unroll
                for (int m = 0; m < 4; ++m)
#pragma unroll
                    for (int bj = 0; bj < 2; ++bj) hw[m][bj] = *(const u32x4*)(HB + off0 + (size_t)m * 16 * D + bj * 128);
#pragma unroll
                for (int m = 0; m < 4; ++m)
#pragma unroll
                    for (int bj = 0; bj < 2; ++bj) { const u32x4 w = hw[m][bj]; hv[m][bj][0] = (f32x4){bflo(w.x), bfhi(w.x), bflo(w.y), bfhi(w.y)}; hv[m][bj][1] = (f32x4){bflo(w.z), bfhi(w.z), bflo(w.w), bfhi(w.w)}; }
            }
#pragma unroll
            for (int m = 0; m < 4; ++m) { float ssq = 0.f;
#pragma unroll
                for (int bj = 0; bj < 2; ++bj) { const size_t off = off0 + (size_t)m * 16 * D + bj * 128;
                    const f32x4 o0 = hv[m][bj][0] + acc[ai][bj][m][0] * scale, o1 = hv[m][bj][1] + acc[ai][bj][m][1] * scale;
                    if constexpr (DST32) { *(f32x4*)(dst32 + off) = o0; *(f32x4*)(dst32 + off + 4) = o1; }
                    else { ssq += (o0.x * o0.x + o0.y * o0.y) + (o0.z * o0.z + o0.w * o0.w) + (o1.x * o1.x + o1.y * o1.y) + (o1.z * o1.z + o1.w * o1.w);
                        u32x4 w; w.x = pk2(o0.x, o0.y); w.y = pk2(o0.z, o0.w); w.z = pk2(o1.x, o1.y); w.w = pk2(o1.z, o1.w); *(u32x4*)(HB + off) = w; } }
                if constexpr (!DST32) { ssq += __shfl_xor(ssq, 16); ssq += __shfl_xor(ssq, 32); if (fq == 0) SS[(size_t)(row0 + m * 16) * 16 + u.pn * 4 + wc] = ssq; } }
        }
    }
};
struct EpiConvIn {
    static constexpr bool PERM = true, AFTER_DRAIN = false; const float* SS; bf16_t* VB; bf16_t* BG;
    DI void operator()(const f32x4 (&acc)[2][2][4][2], const pg8::Unit& u, int wr, int wc, int fr, int fq) const {
        const int row0 = u.pm * 256 + wr * 64 + fr; float rs[2][4]; rstd_rows(rs, SS, row0, fq);
#pragma unroll
        for (int ai = 0; ai < 2; ++ai)
#pragma unroll
            for (int m = 0; m < 4; ++m) { const int row = row0 + ai * 128 + m * 16; const float r1 = rs[ai][m];
                if (u.pn < 8) { const float r2 = r1 * r1; const f32x4 v0 = acc[ai][0][m][0] * acc[ai][1][m][0] * r2, v1 = acc[ai][0][m][1] * acc[ai][1][m][1] * r2;
                    u32x4 w; w.x = pk2(v0.x, v0.y); w.y = pk2(v0.z, v0.w); w.z = pk2(v1.x, v1.y); w.w = pk2(v1.z, v1.w);
                    *(u32x4*)(VB + (size_t)row * D + u.pn * 128 + wc * 32 + 8 * fq) = w; }
                else {
#pragma unroll
                    for (int bj = 0; bj < 2; ++bj) { const f32x4 a = acc[ai][bj][m][0] * r1, b = acc[ai][bj][m][1] * r1;
                        u32x4 w; w.x = pk2(a.x, a.y); w.y = pk2(a.z, a.w); w.z = pk2(b.x, b.y); w.w = pk2(b.z, b.w);
                        *(u32x4*)(BG + (size_t)row * D + (u.pn - 8) * 256 + bj * 128 + wc * 32 + 8 * fq) = w; } } }
    }
};
struct EpiKV {
    static constexpr bool PERM = true, AFTER_DRAIN = false; const float* SS; bf16_t* KV; const float* knorm;
    DI void operator()(const f32x4 (&acc)[2][2][4][2], const pg8::Unit& u, int wr, int wc, int fr, int fq) const {
        const int slot = u.pn; const bool nrm = (slot == 2) || (slot == 4); const float* gn = knorm + (slot == 2 ? 64 : 128);
        f32x4 gv[2][2];
#pragma unroll
        for (int bj = 0; bj < 2; ++bj)
#pragma unroll
            for (int n = 0; n < 2; ++n) gv[bj][n] = nrm ? *(const f32x4*)(gn + bj * 32 + 8 * fq + 4 * n) : (f32x4){1.f, 1.f, 1.f, 1.f};
        float rsv[2][4]; rstd_rows(rsv, SS, u.pm * 256 + wr * 64 + fr, fq);
#pragma unroll
        for (int ai = 0; ai < 2; ++ai)
#pragma unroll
            for (int m = 0; m < 4; ++m) { const int row = u.pm * 256 + ai * 128 + wr * 64 + m * 16 + fr; const float rs = rsv[ai][m];
                f32x4 x[2][2]; float ss = 0.f;
#pragma unroll
                for (int bj = 0; bj < 2; ++bj)
#pragma unroll
                    for (int n = 0; n < 2; ++n) { x[bj][n] = acc[ai][bj][m][n] * rs; const f32x4 q = x[bj][n] * x[bj][n]; ss += (q.x + q.y) + (q.z + q.w); }
                ss += __shfl_xor(ss, 16); ss += __shfl_xor(ss, 32);
                const float rn = nrm ? rsqrtf(ss * (1.f / HD) + EPS) : 1.f;
                const int b = row >> 11, s = row & 2047;
                bf16_t* dst = KV + (size_t)slot * KVSLOT + ((size_t)(b * 4 + wc) * SEQ + s) * HD + 8 * fq;
#pragma unroll
                for (int bj = 0; bj < 2; ++bj) { const f32x4 y0 = x[bj][0] * gv[bj][0] * rn, y1 = x[bj][1] * gv[bj][1] * rn;
                    u32x4 w; w.x = pk2(y0.x, y0.y); w.y = pk2(y0.z, y0.w); w.z = pk2(y1.x, y1.y); w.w = pk2(y1.z, y1.w); *(u32x4*)(dst + bj * 32) = w; } }
    }
};
struct EpiQG {
    static constexpr bool PERM = true, AFTER_DRAIN = false; const float* SS; bf16_t* QB; float* GATE; const float* qnorm;
    DI void operator()(const f32x4 (&acc)[2][2][4][2], const pg8::Unit& u, int wr, int wc, int fr, int fq) const {
        f32x4 gv[2][2];
#pragma unroll
        for (int bj = 0; bj < 2; ++bj)
#pragma unroll
            for (int n = 0; n < 2; ++n) gv[bj][n] = *(const f32x4*)(qnorm + bj * 32 + 8 * fq + 4 * n);
        float rsv[2][4]; rstd_rows(rsv, SS, u.pm * 256 + wr * 64 + fr, fq);
#pragma unroll
        for (int ai = 0; ai < 2; ++ai)
#pragma unroll
            for (int m = 0; m < 4; ++m) { const int row = u.pm * 256 + ai * 128 + wr * 64 + m * 16 + fr; const float rs = rsv[ai][m];
                if (u.pn < 4) {
                    f32x4 x[2][2]; float ss = 0.f;
#pragma unroll
                    for (int bj = 0; bj < 2; ++bj)
#pragma unroll
                        for (int n = 0; n < 2; ++n) { x[bj][n] = acc[ai][bj][m][n] * rs; const f32x4 q = x[bj][n] * x[bj][n]; ss += (q.x + q.y) + (q.z + q.w); }
                    ss += __shfl_xor(ss, 16); ss += __shfl_xor(ss, 32);
                    const float rn = rsqrtf(ss * (1.f / HD) + EPS) * QSCALE;
                    bf16_t* dst = QB + (size_t)row * D + (u.pn * 4 + wc) * HD + 8 * fq;
#pragma unroll
                    for (int bj = 0; bj < 2; ++bj) { const f32x4 y0 = x[bj][0] * gv[bj][0] * rn, y1 = x[bj][1] * gv[bj][1] * rn;
                        u32x4 w; w.x = pk2(y0.x, y0.y); w.y = pk2(y0.z, y0.w); w.z = pk2(y1.x, y1.y); w.w = pk2(y1.z, y1.w); *(u32x4*)(dst + bj * 32) = w; }
                } else {
#pragma unroll
                    for (int n = 0; n < 2; ++n) { const int c = wc * 32 + 8 * fq + 4 * n;
                        if (c < NGATE) { const f32x4 v = acc[ai][0][m][n] * rs; f32x4 o; o.x = sigm(v.x); o.y = sigm(v.y); o.z = sigm(v.z); o.w = sigm(v.w);
                            *(f32x4*)(GATE + (size_t)row * NGATE + c) = o; } }
                } }
    }
};
struct EpiHid {
    static constexpr bool PERM = true, AFTER_DRAIN = false; const float* bias; bf16_t* HID;
    DI static float gelu(float x) { const float z2 = 1.5957691216f * (x + 0.044715f * x * x * x); return x * sigm(z2); }
    DI void operator()(const f32x4 (&acc)[2][2][4][2], const pg8::Unit& u, int wr, int wc, int fr, int fq) const {
#pragma unroll
        for (int ai = 0; ai < 2; ++ai)
#pragma unroll
            for (int m = 0; m < 4; ++m) { const int row = u.pm * 256 + ai * 128 + wr * 64 + m * 16 + fr;
#pragma unroll
                for (int bj = 0; bj < 2; ++bj) { const int col0 = bj * 128 + wc * 32 + 8 * fq;
                    const f32x4 v0 = acc[ai][bj][m][0] + *(const f32x4*)(bias + col0), v1 = acc[ai][bj][m][1] + *(const f32x4*)(bias + col0 + 4);
                    u32x4 w; w.x = pk2(gelu(v0.x), gelu(v0.y)); w.y = pk2(gelu(v0.z), gelu(v0.w)); w.z = pk2(gelu(v1.x), gelu(v1.y)); w.w = pk2(gelu(v1.z), gelu(v1.w));
                    *(u32x4*)(HID + (size_t)row * 256 + col0) = w; } }
    }
};

DI int colmap(int mapid, int p) {
    if (mapid == 1) { const int j = (p >> 8) * 128 + (p & 127); return ((p >> 7) & 1) ? DFF + j : j; }
    if (mapid == 2) { if (p < 2048) { const int j = (p >> 8) * 128 + (p & 127); return ((p >> 7) & 1) ? 2048 + j : 1024 + j; } return p - 2048; }
    if (mapid == 3 || (mapid == 4 && p < 1024)) { const int t = p >> 8, q = p & 255; return t * 256 + ((q >> 5) & 3) * 64 + (q >> 7) * 32 + (q & 31); }
    if (mapid == 4) return p < NQG ? p : -1;
    return p;
}
struct Job { const float* W; bf16_t* WT; const float* gain; int K, Nsrc, P, mapid; };
DI void transpose_item(const Job& j, int item, LAS float* scr, int lane) {
    const int nblk = j.P / 32, kb = item / nblk, nb = item % nblk, k0 = 64 * kb, p0 = 32 * nb;
    const int L = colmap(j.mapid, p0 + (lane & 31));
    float v[32];
#pragma unroll
    for (int i = 0; i < 32; ++i) { const int kk = 2 * i + (lane >> 5); v[i] = (L >= 0) ? j.W[(size_t)(k0 + kk) * j.Nsrc + L] : 0.f; }
    if (j.gain) {
#pragma unroll
        for (int i = 0; i < 32; ++i) v[i] *= j.gain[k0 + 2 * i + (lane >> 5)]; }
#pragma unroll
    for (int i = 0; i < 32; ++i) scr[(2 * i + (lane >> 5)) * 33 + (lane & 31)] = v[i];
    asm volatile("s_waitcnt lgkmcnt(0)" ::: "memory");
    const int c = lane & 7;
#pragma unroll
    for (int q = 0; q < 4; ++q) { const int n = (lane >> 3) + 8 * q; const LAS float* s = scr + (8 * c) * 33 + n;
        u32x4 o; o.x = pk2(s[0 * 33], s[1 * 33]); o.y = pk2(s[2 * 33], s[3 * 33]); o.z = pk2(s[4 * 33], s[5 * 33]); o.w = pk2(s[6 * 33], s[7 * 33]);
        *(u32x4*)(j.WT + (size_t)(p0 + n) * j.K + k0 + 8 * c) = o; }
    asm volatile("s_waitcnt lgkmcnt(0)" ::: "memory");
}
DI float wave_sum(float v) {
#pragma unroll
    for (int o = 1; o < 64; o <<= 1) v += __shfl_xor(v, o);
    return v;
}
namespace cv {
constexpr int I_GU = 16 * 176, I_D = 44 * 32, I_CIN = 16 * 96, I_SQ = 16 * 32, I_KV = 16 * 48, I_QG = 16 * 40, I_C1 = 32 * 8, I_C2 = 4 * 2;
constexpr int E0 = I_GU;
constexpr int E1 = E0 + I_D + I_CIN + I_SQ + I_GU;
constexpr int E2 = E1 + I_D + I_KV + I_GU + I_D + I_QG + 2 * I_C1 + 2 * I_C2;
constexpr int E3 = E2 + I_SQ + I_GU;
constexpr int E4 = E3 + I_D;
}
DI void convert_items(const Args& a, LAS unsigned char* lds, int first, int last, int worker, int nworkers) {
    using namespace cv;
    const int lane = threadIdx.x & 63, wave = __builtin_amdgcn_readfirstlane(threadIdx.x >> 6);
    LAS float* scr = (LAS float*)(lds + wave * 16384);
    unsigned char* ws = a.ws;
    for (int it = first + worker; it < last; it += nworkers) {
        int r = it; Job j;
#define GUJ(q) Job{a.w_gu + (size_t)(q) * WGU_ELEMS, (bf16_t*)(ws + WS_WGU) + (size_t)(q) * WGU_ELEMS, a.ffn_norm + (q) * D, D, 2 * DFF, 2 * DFF, 1}
#define DJ(q) Job{a.w_down + (size_t)(q) * WD_ELEMS, (bf16_t*)(ws + WS_WD) + (size_t)(q) * WD_ELEMS, nullptr, DFF, D, D, 0}
        if (r < I_GU) { j = GUJ(0); }
        else if ((r -= I_GU) < I_D) { j = DJ(0); }
        else if ((r -= I_D) < I_CIN) { j = Job{a.conv_w_in, (bf16_t*)(ws + WS_WCIN), a.mix_norm, D, 3 * D, 3 * D, 2}; }
        else if ((r -= I_CIN) < I_SQ) { j = Job{a.conv_w_out, (bf16_t*)(ws + WS_WCOUT), nullptr, D, D, D, 0}; }
        else if ((r -= I_SQ) < I_GU) { j = GUJ(1); }
        else if ((r -= I_GU) < I_D) { j = DJ(1); }
        else if ((r -= I_D) < I_KV) { j = Job{a.kv_w, (bf16_t*)(ws + WS_WKV), a.kv_norm, D, NKV, NKV, 3}; }
        else if ((r -= I_KV) < I_GU) { j = GUJ(2); }
        else if ((r -= I_GU) < I_D) { j = DJ(2); }
        else if ((r -= I_D) < I_QG) { j = Job{a.w_qg, (bf16_t*)(ws + WS_WQG), a.mix_norm + D, D, NQG, NQGP, 4}; }
        else if ((r -= I_QG) < 2 * I_C1) { const int q = r / I_C1; r -= q * I_C1; j = Job{a.cmp_w1 + (size_t)q * 2048 * 256, (bf16_t*)(ws + WS_WC1) + (size_t)q * 2048 * 256, nullptr, 2048, 256, 256, 0}; }
        else if ((r -= 2 * I_C1) < 2 * I_C2) { const int q = r / I_C2; r -= q * I_C2; j = Job{a.cmp_w2 + (size_t)q * 256 * 64, (bf16_t*)(ws + WS_WC2T) + (size_t)q * 256 * 64, nullptr, 256, 64, 64, 0}; }
        else if ((r -= 2 * I_C2) < I_SQ) { j = Job{a.w_o, (bf16_t*)(ws + WS_WO), nullptr, D, D, D, 0}; }
        else if ((r -= I_SQ) < I_GU) { j = GUJ(3); }
        else { r -= I_GU; j = DJ(3); }
#undef GUJ
#undef DJ
        transpose_item(j, r, scr, lane);
    }
}
DI void prologue(const Args& a, LAS unsigned char* lds) {
    const int tid = threadIdx.x, lane = tid & 63, wave = __builtin_amdgcn_readfirstlane(tid >> 6);
    const int gw = blockIdx.x * 8 + wave, NGW = gridDim.x * 8;
    unsigned char* ws = a.ws;
    convert_items(a, lds, 0, cv::E0, gw, NGW);
    bf16_t* HB = (bf16_t*)(ws + WS_HB); float* SS = (float*)(ws + WS_SS);
    const bool byx = (gridDim.x % 8 == 0);
    const int rbase = byx ? (int)(blockIdx.x % 8) * (M / 8) : 0, rend = byx ? rbase + M / 8 : M;
    const int rw = byx ? (int)(blockIdx.x / 8) * 8 + wave : gw, rstep = byx ? (int)(gridDim.x / 8) * 8 * 4 : NGW * 4;
    for (int m0 = rbase + rw * 4; m0 < rend; m0 += rstep) {
        f32x4 v[4][4];
#pragma unroll
        for (int rr = 0; rr < 4; ++rr)
#pragma unroll
            for (int q = 0; q < 4; ++q) v[rr][q] = *((const f32x4*)(a.x + (size_t)(m0 + rr) * D) + lane + 64 * q);
#pragma unroll
        for (int rr = 0; rr < 4; ++rr) { float s = 0.f; unsigned long long* o8 = (unsigned long long*)(HB + (size_t)(m0 + rr) * D) + lane;
#pragma unroll
            for (int q = 0; q < 4; ++q) { const f32x4 w = v[rr][q]; s += (w.x * w.x + w.y * w.y) + (w.z * w.z + w.w * w.w);
                o8[64 * q] = (unsigned long long)pk2(w.x, w.y) | ((unsigned long long)pk2(w.z, w.w) << 32); }
            s = wave_sum(s);
            if (lane < 16) SS[(size_t)(m0 + rr) * 16 + lane] = (lane == 0) ? s : 0.f; }
    }
    for (int c = gw; c < 512; c += NGW) { const int slot = c >> 8, col = c & 255; float s = 0.f;
        const float* pos = a.cmp_pos + slot * 2048; const float* w1 = a.cmp_w1 + (size_t)slot * 2048 * 256 + col;
        for (int k = lane; k < 2048; k += 64) s += pos[k] * w1[(size_t)k * 256];
        s = wave_sum(s);
        if (lane == 0) ((float*)(ws + WS_BIASC))[c] = s + a.cmp_b1[c]; }
}

DI void conv_phase(const Args& a) {
    const bf16_t* VB = (const bf16_t*)(a.ws + WS_VB); const bf16_t* BG = (const bf16_t*)(a.ws + WS_BG); bf16_t* Y = (bf16_t*)(a.ws + WS_Y);
    const bool byx = (gridDim.x % 8 == 0);
    const int ibase = byx ? (int)(blockIdx.x % 8) * (M / 8) * 128 : 0, iend = byx ? ibase + (M / 8) * 128 : M * 128;
    const int nth = byx ? (int)(gridDim.x / 8) * 512 : (int)gridDim.x * 512, ifirst = ibase + (byx ? (int)(blockIdx.x / 8) : (int)blockIdx.x) * 512 + (int)threadIdx.x;
    for (int idx = ifirst; idx < iend; idx += nth) {
        const int m = idx >> 7, k0 = (idx & 127) * 8, s = m & (SEQ - 1); const size_t off = (size_t)m * D + k0;
        const u32x4 z = {0u, 0u, 0u, 0u};
        const u32x4 v0 = *(const u32x4*)(VB + off), v1 = s >= 1 ? *(const u32x4*)(VB + off - D) : z, v2 = s >= 2 ? *(const u32x4*)(VB + off - 2 * D) : z, bg = *(const u32x4*)(BG + off);
        const f32x4 c0a = *(const f32x4*)(a.conv_w + k0), c0b = *(const f32x4*)(a.conv_w + k0 + 4), c1a = *(const f32x4*)(a.conv_w + D + k0), c1b = *(const f32x4*)(a.conv_w + D + k0 + 4),
                    c2a = *(const f32x4*)(a.conv_w + 2 * D + k0), c2b = *(const f32x4*)(a.conv_w + 2 * D + k0 + 4);
        float w0[8] = {c0a.x, c0a.y, c0a.z, c0a.w, c0b.x, c0b.y, c0b.z, c0b.w}, w1[8] = {c1a.x, c1a.y, c1a.z, c1a.w, c1b.x, c1b.y, c1b.z, c1b.w}, w2[8] = {c2a.x, c2a.y, c2a.z, c2a.w, c2b.x, c2b.y, c2b.z, c2b.w};
        u32x4 o;
#pragma unroll
        for (int q = 0; q < 4; ++q) {
            const float lo = bflo(bg[q]) * (w0[2 * q] * bflo(v2[q]) + w1[2 * q] * bflo(v1[q]) + w2[2 * q] * bflo(v0[q]));
            const float hi = bfhi(bg[q]) * (w0[2 * q + 1] * bfhi(v2[q]) + w1[2 * q + 1] * bfhi(v1[q]) + w2[2 * q + 1] * bfhi(v0[q]));
            o[q] = pk2(lo, hi); }
        *(u32x4*)(Y + off) = o;
    }
}

DI int crow(int reg, int h) { return (reg & 3) + 8 * (reg >> 2) + 4 * h; }
#define MFMA32(a, b, c) __builtin_amdgcn_mfma_f32_32x32x16_bf16((a), (b), (c), 0, 0, 0)
DI void cmp2_unit(const Args& a, int slot, int rg) {
    const int tid = threadIdx.x, lane = tid & 63, r = lane & 31, h = lane >> 5;
    {
        const bf16_t* HID = (const bf16_t*)(a.ws + WS_HID) + (size_t)slot * 4096 * 256 + (size_t)(32 * rg + r) * 256 + 8 * h;
        const bf16_t* W2T = (const bf16_t*)(a.ws + WS_WC2T) + (size_t)slot * 64 * 256 + (size_t)r * 256 + 8 * h;
        f32x16 o[2]; o[0] = f32x16{}; o[1] = f32x16{};
#pragma unroll 4
        for (int kk = 0; kk < 16; ++kk) { const bf16x8 hb = *(const bf16x8*)(HID + 16 * kk);
            const bf16x8 w0 = *(const bf16x8*)(W2T + 16 * kk), w1 = *(const bf16x8*)(W2T + 32 * 256 + 16 * kk);
            o[0] = MFMA32(w0, hb, o[0]); o[1] = MFMA32(w1, hb, o[1]); }
        float rn = 1.f;
        if (slot == 0) { float ss = 0.f;
#pragma unroll
            for (int dt = 0; dt < 2; ++dt)
#pragma unroll
                for (int q = 0; q < 16; ++q) ss += o[dt][q] * o[dt][q];
            ss += __shfl_xor(ss, 32); rn = rsqrtf(ss * (1.f / HD) + EPS); }
        bf16_t* dst = (bf16_t*)(a.ws + (slot == 0 ? WS_KCMP : WS_VCMP)) + (size_t)(32 * rg + r) * 64;
#pragma unroll
        for (int dt = 0; dt < 2; ++dt)
#pragma unroll
            for (int gq = 0; gq < 4; ++gq) { const int d = 32 * dt + 8 * gq + 4 * h; f32x4 g = {1.f, 1.f, 1.f, 1.f}; if (slot == 0) g = *(const f32x4*)(a.k_norm + d);
                u32x2 w; w.x = pk2(o[dt][4 * gq] * rn * g.x, o[dt][4 * gq + 1] * rn * g.y); w.y = pk2(o[dt][4 * gq + 2] * rn * g.z, o[dt][4 * gq + 3] * rn * g.w);
                *(u32x2*)(dst + d) = w; }
    }
}

namespace nsa {
constexpr int ROWB = 144;
constexpr int TILEB = 64 * ROWB;
constexpr int L_KV = 0;
constexpr int L_S4 = 36864;
constexpr int L_LS = L_S4 + 4 * 64 * 33 * 4;
constexpr int L_IMP = L_LS + 4 * 64 * 33 * 4;
constexpr int L_SELM = L_IMP + 64 * 33 * 4;
constexpr int L_END = L_SELM + 65 * 4;
static_assert(L_END <= 131072, "nsa LDS map");
DI s16x4 vtr(LAS const char* p) { return __builtin_bit_cast(s16x4, __builtin_amdgcn_ds_read_tr16_b64_v4i16((LAS v4i16_t*)p)); }
DI void qk_tile(f32x16& st, LAS const char* kb, const bf16x8 (&qf)[4]) {
    st = f32x16{};
#pragma unroll
    for (int kk = 0; kk < 4; ++kk) { const bf16x8 kf = *(LAS const bf16x8*)(kb + kk * 32); st = MFMA32(kf, qf[kk], st); }
}
DI void pv_tile(f32x16 (&o)[2], const f32x16& p, LAS const char* vb) {
#pragma unroll
    for (int s = 0; s < 2; ++s) {
        u32x4 w; w.x = pk2(p[8 * s], p[8 * s + 1]); w.y = pk2(p[8 * s + 2], p[8 * s + 3]); w.z = pk2(p[8 * s + 4], p[8 * s + 5]); w.w = pk2(p[8 * s + 6], p[8 * s + 7]);
        const bf16x8 pb = __builtin_bit_cast(bf16x8, w);
#pragma unroll
        for (int dt = 0; dt < 2; ++dt) { const s16x4 lo = vtr(vb + (16 * s) * ROWB + dt * 64), hi = vtr(vb + (16 * s + 8) * ROWB + dt * 64);
            const bf16x8 va = __builtin_shufflevector(lo, hi, 0, 1, 2, 3, 4, 5, 6, 7);
            o[dt] = MFMA32(va, pb, o[dt]); }
    }
}
DI void nsa_step(LAS char* lds, int i, int j_cur, int n_sel, int tb, unsigned selm, int tlh, float g1, int koff, int voff, const bf16x8 (&qf)[4],
                 f32x16 (&acc)[2], f32x16 (&tot)[2], float& l_run) {
    if (i == n_sel) {
        const float lt = l_run + __shfl_xor(l_run, 32); const float sc = g1 / lt;
        tot[0] += acc[0] * sc; tot[1] += acc[1] * sc; acc[0] = f32x16{}; acc[1] = f32x16{}; l_run = 0.f; }
    const bool is_win = (i >= n_sel);
    const bool lane_ok = is_win ? true : (((selm >> j_cur) & 1u) != 0u);
    if (__any(lane_ok)) {
        LAS const char* kbuf = lds + L_KV + (i & 1) * 2 * TILEB; LAS const char* vbuf = kbuf + TILEB;
        bf16x8 kf[2][4]; s16x4 vlo[2][2][2], vhi[2][2][2];
#pragma unroll
        for (int c = 0; c < 2; ++c)
#pragma unroll
            for (int kk = 0; kk < 4; ++kk) kf[c][kk] = *(LAS const bf16x8*)(kbuf + (32 * c) * ROWB + koff + kk * 32);
        __builtin_amdgcn_sched_barrier(0);
        f32x16 st[2]; st[0] = f32x16{}; st[1] = f32x16{};
#pragma unroll
        for (int kk = 0; kk < 4; ++kk) { st[0] = MFMA32(kf[0][kk], qf[kk], st[0]); st[1] = MFMA32(kf[1][kk], qf[kk], st[1]); }
        __builtin_amdgcn_sched_barrier(0);
#pragma unroll
        for (int c = 0; c < 2; ++c)
#pragma unroll
            for (int sx = 0; sx < 2; ++sx)
#pragma unroll
                for (int dt = 0; dt < 2; ++dt) { vlo[c][sx][dt] = vtr(vbuf + voff + (32 * c + 16 * sx) * ROWB + dt * 64); vhi[c][sx][dt] = vtr(vbuf + voff + (32 * c + 16 * sx + 8) * ROWB + dt * 64); }
        __builtin_amdgcn_sched_barrier(0);
        const bool causal = (j_cur == tb), lower = is_win && (j_cur == tb - 8);
        if (causal || lower || !__all(lane_ok)) {
#pragma unroll
            for (int c = 0; c < 2; ++c)
#pragma unroll
                for (int q = 0; q < 16; ++q) { const int kl = 32 * c + crow(q, 0);
                    const bool masked = (!lane_ok) || (causal && kl > tlh) || (lower && kl <= tlh);
                    if (masked) st[c][q] = NEG; }
        }
        float ls0 = 0.f, ls1 = 0.f;
#pragma unroll
        for (int q = 0; q < 16; ++q) { const float p0 = __builtin_amdgcn_exp2f(st[0][q]), p1 = __builtin_amdgcn_exp2f(st[1][q]); st[0][q] = p0; st[1][q] = p1; ls0 += p0; ls1 += p1; }
        l_run += ls0 + ls1;
#pragma unroll
        for (int c = 0; c < 2; ++c)
#pragma unroll
            for (int sx = 0; sx < 2; ++sx) {
                u32x4 w; w.x = pk2(st[c][8 * sx], st[c][8 * sx + 1]); w.y = pk2(st[c][8 * sx + 2], st[c][8 * sx + 3]); w.z = pk2(st[c][8 * sx + 4], st[c][8 * sx + 5]); w.w = pk2(st[c][8 * sx + 6], st[c][8 * sx + 7]);
                const bf16x8 pb = __builtin_bit_cast(bf16x8, w);
#pragma unroll
                for (int dt = 0; dt < 2; ++dt) { const bf16x8 va = __builtin_shufflevector(vlo[c][sx][dt], vhi[c][sx][dt], 0, 1, 2, 3, 4, 5, 6, 7); acc[dt] = MFMA32(va, pb, acc[dt]); } }
    }
}
DI void nsa_unit(LAS char* lds, int b, int g, int tb, const bf16_t* QB, const float* GATE, const bf16_t* KV, const bf16_t* KCMP, const bf16_t* VCMP, bf16_t* OB) {
    const int tid = threadIdx.x, lane = tid & 63, wave = __builtin_amdgcn_readfirstlane(tid >> 6), r = lane & 31, h = lane >> 5;
    const int hh = wave & 3, th = wave >> 2, head = g * 4 + hh, bg = b * 4 + g;
    const int t0 = tb * 64, tl = th * 32 + r, t = t0 + tl; const size_t m = (size_t)b * SEQ + t;
    bf16x8 qf[4];
#pragma unroll
    for (int kk = 0; kk < 4; ++kk) qf[kk] = *(const bf16x8*)(QB + m * D + head * HD + kk * 16 + h * 8);
    const float g0 = GATE[m * NGATE + head * 3 + 0], g1 = GATE[m * NGATE + head * 3 + 1], g2 = GATE[m * NGATE + head * 3 + 2];
    const bf16_t* Ksel = KV + 2 * KVSLOT + (size_t)bg * SEQ * HD + tid * 8; const bf16_t* Kwin = KV + 4 * KVSLOT + (size_t)bg * SEQ * HD + tid * 8;
    u32x4 kA = *(const u32x4*)Ksel, vA = *(const u32x4*)(Ksel + KVSLOT);
    LAS unsigned* SELM = (LAS unsigned*)(lds + L_SELM);
    if (tid < 65) SELM[tid] = 0u;
#pragma unroll
    for (int i = 0; i < 2; ++i) { const int c = tid + 512 * i, row = c >> 3, ch = c & 7;
        *(LAS u32x4*)(lds + L_KV + row * ROWB + ch * 16) = *(const u32x4*)(KCMP + (size_t)bg * 8192 + c * 8);
        *(LAS u32x4*)(lds + L_KV + (128 + row) * ROWB + ch * 16) = *(const u32x4*)(VCMP + (size_t)bg * 8192 + c * 8); }
    __syncthreads();
    const int i16 = lane & 15, q4 = i16 >> 2, p4 = i16 & 3, blk = (lane >> 4) & 1;
    const int koff = r * ROWB + h * 16, voff = (4 * h + q4) * ROWB + blk * 32 + p4 * 8;
    f32x16 tot[2];
    {
        f32x16 st[4];
        const int tmaxw = t0 + 32 * th + 31, nmaxw = (tmaxw - 31) >> 4;
#pragma unroll
        for (int c = 0; c < 4; ++c) { if (32 * c <= nmaxw) qk_tile(st[c], lds + L_KV + (32 * c) * ROWB + koff, qf); else st[c] = f32x16{}; }
        const int nmax = ((t >= 31) ? ((t - 31) >> 4) : -1) - 4 * h;
        float mx = NEG;
#pragma unroll
        for (int c = 0; c < 4; ++c)
#pragma unroll
            for (int q = 0; q < 16; ++q) { const int n = 32 * c + crow(q, 0); if (n > nmax) st[c][q] = NEG; mx = fmaxf(mx, st[c][q]); }
        mx = fmaxf(mx, __shfl_xor(mx, 32));
        float sum = 0.f;
#pragma unroll
        for (int c = 0; c < 4; ++c)
#pragma unroll
            for (int q = 0; q < 16; ++q) { const int n = 32 * c + crow(q, 0); const float p = (n <= nmax && 32 * c <= nmaxw) ? __builtin_amdgcn_exp2f(st[c][q] - mx) : 0.f; st[c][q] = p; sum += p; }
        sum += __shfl_xor(sum, 32);
        const float inv = sum > 0.f ? 1.f / sum : 0.f;
#pragma unroll
        for (int c = 0; c < 4; ++c) st[c] = st[c] * inv;
        if (tb > 15) {
            LAS float* S4 = (LAS float*)(lds + L_S4) + (hh * 64 + tl) * 33; LAS float* LS = (LAS float*)(lds + L_LS) + (hh * 64 + tl) * 33;
#pragma unroll
            for (int c = 0; c < 4; ++c)
#pragma unroll
                for (int gq = 0; gq < 4; ++gq) { const int ch = 8 * c + 2 * gq + h;
                    S4[ch] = (st[c][4 * gq] + st[c][4 * gq + 1]) + (st[c][4 * gq + 2] + st[c][4 * gq + 3]);
                    if (ch < 31) LS[ch + 1] = st[c][4 * gq + 3]; else LS[0] = 0.f; }
        }
        f32x16 o[2]; o[0] = f32x16{}; o[1] = f32x16{};
#pragma unroll
        for (int c = 0; c < 4; ++c) if (32 * c <= nmaxw) pv_tile(o, st[c], lds + L_KV + (128 + 32 * c) * ROWB + voff);
        tot[0] = o[0] * g0; tot[1] = o[1] * g0;
    }
    __syncthreads();
    if (tb > 15) {
        const int tt = tid >> 3, jj = tid & 7;
        LAS const float* S4 = (LAS const float*)(lds + L_S4); LAS const float* LS = (LAS const float*)(lds + L_LS); LAS float* IMP = (LAS float*)(lds + L_IMP);
#pragma unroll
        for (int i = 0; i < 4; ++i) { const int j = jj + 8 * i; float v = 0.f;
#pragma unroll
            for (int q = 0; q < 4; ++q) v += S4[(q * 64 + tt) * 33 + j] + LS[(q * 64 + tt) * 33 + j];
            if (j == 0 || j == tb || j == tb - 1) v = 1e9f;
            if (j > tb) v = NEG;
            IMP[tt * 33 + j] = v; }
        __syncthreads();
        unsigned bits = 0u;
        float vv[4]; int rank[4];
#pragma unroll
        for (int i = 0; i < 4; ++i) { vv[i] = IMP[tt * 33 + jj + 8 * i]; rank[i] = 0; }
#pragma unroll 1
        for (int j2 = 0; j2 <= tb; ++j2) { const float v2 = IMP[tt * 33 + j2];
#pragma unroll
            for (int i = 0; i < 4; ++i) rank[i] += (v2 > vv[i] || (v2 == vv[i] && j2 < jj + 8 * i)) ? 1 : 0; }
#pragma unroll
        for (int i = 0; i < 4; ++i) { const int j = jj + 8 * i; if (rank[i] < 16 && j <= tb) bits |= 1u << j; }
        if (bits) { atomicOr((unsigned*)&SELM[tt], bits); atomicOr((unsigned*)&SELM[64], bits); }
        __syncthreads();
    }
    const unsigned allm = (2u << tb) - 1u;
    const unsigned selm = tb > 15 ? SELM[tl] : allm, umask = tb > 15 ? SELM[64] : allm;
    const int n_sel = __builtin_popcount(umask), jw0 = tb > 8 ? tb - 8 : 0, n_steps = n_sel + (tb - jw0 + 1);
    unsigned pf_rem = umask & ~1u; int pf_i = 1, jA = 0, jB = 0, j_cur;
    u32x4 kB, vB;
#define NSA_LOAD(KR, VR, JR) do { const bf16_t* kp_; if (pf_i < n_sel) { JR = __builtin_ctz(pf_rem); pf_rem &= pf_rem - 1u; kp_ = Ksel; } else { JR = jw0 + (pf_i - n_sel); JR = JR > tb ? tb : JR; kp_ = Kwin; } ++pf_i; \
        KR = *(const u32x4*)(kp_ + (size_t)JR * 64 * HD); VR = *(const u32x4*)(kp_ + KVSLOT + (size_t)JR * 64 * HD); } while (0)
#define NSA_STORE(buf, KR, VR) do { LAS char* d_ = lds + L_KV + (buf) * 2 * TILEB + (tid >> 3) * ROWB + (tid & 7) * 16; *(LAS u32x4*)d_ = KR; *(LAS u32x4*)(d_ + TILEB) = VR; } while (0)
    j_cur = 0; NSA_STORE(0, kA, vA);
    NSA_LOAD(kA, vA, jA);
    __syncthreads();
    const int tlh = tl - 4 * h;
    float l_run = 0.f; f32x16 acc[2]; acc[0] = f32x16{}; acc[1] = f32x16{};
    for (int i = 0; i < n_steps; i += 2) {
        NSA_LOAD(kB, vB, jB);
        nsa_step(lds, i, j_cur, n_sel, tb, selm, tlh, g1, koff, voff, qf, acc, tot, l_run);
        if (i + 1 < n_steps) NSA_STORE((i + 1) & 1, kA, vA);
        j_cur = jA;
        __syncthreads();
        if (i + 1 >= n_steps) break;
        NSA_LOAD(kA, vA, jA);
        nsa_step(lds, i + 1, j_cur, n_sel, tb, selm, tlh, g1, koff, voff, qf, acc, tot, l_run);
        if (i + 2 < n_steps) NSA_STORE((i + 2) & 1, kB, vB);
        j_cur = jB;
        __syncthreads();
    }
    {   const float lt = l_run + __shfl_xor(l_run, 32); const float sc = g2 / lt; tot[0] += acc[0] * sc; tot[1] += acc[1] * sc; }
    bf16_t* dst = OB + m * D + head * HD + 4 * h;
#pragma unroll
    for (int dt = 0; dt < 2; ++dt)
#pragma unroll
        for (int gq = 0; gq < 4; ++gq) { u32x2 w; w.x = pk2(tot[dt][4 * gq], tot[dt][4 * gq + 1]); w.y = pk2(tot[dt][4 * gq + 2], tot[dt][4 * gq + 3]);
            *(u32x2*)(dst + 32 * dt + 8 * gq) = w; }
#undef NSA_LOAD
#undef NSA_STORE
}
DI void nsa_phase(const Args& a, LAS char* lds) {
    const bf16_t* QB = (const bf16_t*)(a.ws + WS_QB); const float* GATE = (const float*)(a.ws + WS_GATE); const bf16_t* KV = (const bf16_t*)(a.ws + WS_KV);
    const bf16_t* KCMP = (const bf16_t*)(a.ws + WS_KCMP); const bf16_t* VCMP = (const bf16_t*)(a.ws + WS_VCMP); bf16_t* OB = (bf16_t*)(a.ws + WS_OB);
    const int Gn = gridDim.x, vcu = (Gn % 8 == 0) ? (blockIdx.x % 8) * (Gn / 8) + blockIdx.x / 8 : blockIdx.x;
    for (int u = vcu; u < 1024; u += Gn) {
        const int c = u & 255, rnd = u >> 8, bgi = c >> 3, s = c & 7;
        const int tb = rnd == 0 ? s : rnd == 1 ? 15 - s : rnd == 2 ? 16 + s : 31 - s;
        nsa_unit(lds, bgi >> 2, bgi & 3, tb, QB, GATE, KV, KCMP, VCMP, OB);
    }
}
}

#define XB_TMO      128
#define XB_XCNT(j)  (256  + 64 * (j))
#define XB_XSUB(j)  (1280 + 64 * (j))
#define XB_XGEN(j)  (2304 + 64 * (j))
#define XB_TOP      3328
#define XB_TOPGEN   3392
#define XCD_BAR_WORDS 3456
#define XB_SPIN_CAP (1u << 18)

__device__ __forceinline__ unsigned xb_ld(unsigned* p)              { return __hip_atomic_load(p, __ATOMIC_RELAXED, __HIP_MEMORY_SCOPE_AGENT); }
__device__ __forceinline__ unsigned xb_add(unsigned* p, unsigned v) { return __hip_atomic_fetch_add(p, v, __ATOMIC_RELAXED, __HIP_MEMORY_SCOPE_AGENT); }
__device__ __forceinline__ unsigned xb_xcc_id() { return (unsigned)__builtin_amdgcn_s_getreg((3 << 11) | 20) & 0xFu; }
#define XB_SPIN(cond, bar) do { unsigned _sp = 0; while (cond) { __builtin_amdgcn_s_sleep(1); \
    if ((++_sp & 255u) == 0u) { if (xb_ld(&(bar)[XB_TMO])) break; if (_sp > XB_SPIN_CAP) { atomicAdd(&(bar)[XB_TMO], 1u); break; } } } } while (0)

struct XcdBarrier {
    unsigned* bar; unsigned x;
    volatile LAS unsigned* st;
};

__device__ __forceinline__ XcdBarrier xcd_barrier_post(unsigned* bar, volatile LAS unsigned* st) {
    XcdBarrier b; b.bar = bar; b.x = xb_xcc_id(); b.st = st;
    if (threadIdx.x == 0) (void)xb_add(&bar[XB_XCNT(b.x)], 1u);
    return b;
}
__device__ __forceinline__ void xcd_barrier_complete(unsigned* bar, unsigned x, unsigned& nloc, unsigned& nx) {
    const unsigned G = gridDim.x * gridDim.y * gridDim.z;
    unsigned sum, cnt, mine, sp = 0u;
    for (;;) {
        sum = 0u; cnt = 0u; mine = 0u;
#pragma unroll
        for (unsigned j = 0; j < 16; ++j) { const unsigned c = xb_ld(&bar[XB_XCNT(j)]); sum += c; cnt += (c > 0u) ? 1u : 0u; mine = (j == x) ? c : mine; }
        if (sum == G) break;
        __builtin_amdgcn_s_sleep(1);
        if ((++sp & 255u) == 0u) { if (xb_ld(&bar[XB_TMO])) break; if (sp > XB_SPIN_CAP) { atomicAdd(&bar[XB_TMO], 1u); break; } }
    }
    nloc = mine > 0u ? mine : 1u; nx = cnt > 0u ? cnt : 1u;
}

__device__ __forceinline__ void xcd_barrier(const XcdBarrier& b) {
    asm volatile("s_waitcnt vmcnt(0)" ::: "memory");
    __syncthreads();
    if (threadIdx.x == 0) {
        unsigned* bar = b.bar;
        __builtin_amdgcn_s_waitcnt(0);
        unsigned nloc = b.st[0], nx = b.st[1];
        if (nloc == 0u) { xcd_barrier_complete(bar, b.x, nloc, nx); b.st[0] = nloc; b.st[1] = nx; }
        const unsigned old = xb_add(&bar[XB_XSUB(b.x)], 1u);
        const unsigned gen = old / nloc;
        if (old + 1u == (gen + 1u) * nloc) {
            __builtin_amdgcn_fence(__ATOMIC_RELEASE, "agent");
            asm volatile("s_waitcnt vmcnt(0)" ::: "memory");
            const unsigned og = xb_add(&bar[XB_TOP], 1u);
            const unsigned tg = og / nx;
            if (og + 1u == (tg + 1u) * nx) xb_add(&bar[XB_TOPGEN], 1u);
            else XB_SPIN(xb_ld(&bar[XB_TOPGEN]) == tg, bar);
            __builtin_amdgcn_fence(__ATOMIC_ACQUIRE, "agent");
            xb_add(&bar[XB_XGEN(b.x)], 1u);
            asm volatile("s_waitcnt vmcnt(0)" ::: "memory");
        } else {
            XB_SPIN(xb_ld(&bar[XB_XGEN(b.x)]) == gen, bar);
            __builtin_amdgcn_fence(__ATOMIC_ACQUIRE, "agent");
            asm volatile("s_waitcnt vmcnt(0)" ::: "memory");
        }
    }
    __syncthreads();
}


__device__ __forceinline__ void xcc_barrier_light(const XcdBarrier& b) {
    asm volatile("s_waitcnt vmcnt(0)" ::: "memory");
    __syncthreads();
    if (threadIdx.x == 0) {
        unsigned* bar = b.bar;
        __builtin_amdgcn_s_waitcnt(0);
        const unsigned nloc = b.st[0];
        const unsigned old = xb_add(&bar[XB_XSUB(b.x)], 1u);
        const unsigned gen = old / nloc;
        if (old + 1u == (gen + 1u) * nloc) xb_add(&bar[XB_XGEN(b.x)], 1u);
        else XB_SPIN(xb_ld(&bar[XB_XGEN(b.x)]) == gen, bar);
        __builtin_amdgcn_fence(__ATOMIC_ACQUIRE, "agent");
        asm volatile("s_waitcnt vmcnt(0)" ::: "memory");
    }
    __syncthreads();
}

__global__ void __launch_bounds__(512, 2) yoco_fwd(Args a) {
    extern __shared__ __attribute__((aligned(16))) unsigned char lds_raw[];
    LAS unsigned char* lds = (LAS unsigned char*)lds_raw;
    cg::grid_group grid = cg::this_grid();
    unsigned char* ws = a.ws;
    volatile LAS unsigned* bst = (volatile LAS unsigned*)(lds + 131072 + 1024);
    if (threadIdx.x < 2) bst[threadIdx.x] = 0u;
    __syncthreads();
    XcdBarrier xbar = xcd_barrier_post((unsigned*)ws, bst);
    unsigned* misplaced = (unsigned*)ws + 8192;
    if (threadIdx.x == 0) __hip_atomic_fetch_or(misplaced + 64 * (blockIdx.x % 8u), 1u << xbar.x, __ATOMIC_RELAXED, __HIP_MEMORY_SCOPE_AGENT);
    bool light_ok = false;
    const int lo = a.ph_lo, hi = a.ph_hi, G = gridDim.x, c0 = blockIdx.x;
#define IN(k) (lo <= (k) && (k) < hi)
#define SEAM(k) do { if (IN(k) && IN((k) + 1)) { \
        const bool loc_ = ((k) == 2 || (k) == 3 || (k) == 4 || (k) == 5 || (k) == 7 || (k) == 8 || (k) == 9 || (k) == 12 || (k) == 13 || (k) == 14);     \
        if (loc_ && light_ok) xcc_barrier_light(xbar); else xcd_barrier(xbar); \
        if ((k) == 0) { unsigned all_ = 0u; bool one_ = true; for (int r_ = 0; r_ < 8; ++r_) { const unsigned m_ = __hip_atomic_load(misplaced + 64 * r_, __ATOMIC_RELAXED, __HIP_MEMORY_SCOPE_AGENT); one_ = one_ && (__builtin_popcount(m_) == 1) && ((all_ & m_) == 0u); all_ |= m_; } \
            light_ok = (G % 8 == 0) && one_; } } } while (0)
    if (hi > NPHASE) grid.sync();
    bf16_t* HB = (bf16_t*)(ws + WS_HB); float* SS = (float*)(ws + WS_SS); bf16_t* ACT = (bf16_t*)(ws + WS_ACT);
    const bf16_t* WGU = (const bf16_t*)(ws + WS_WGU); const bf16_t* WD = (const bf16_t*)(ws + WS_WD);
#define GEMM(EpiT, E, Aptr, Bptr, NN, KK, LDA, cc) do { pg8::Gemm g_{(Aptr), (Bptr), M, (NN), (KK), (LDA)}; pg8::StaticOrder S_; S_.init(M, (NN), G, (cc)); \
        pg8::gemm_phase<EpiT, pg8::StaticOrder, true, true>(lds, g_, S_, (E)); } while (0)
    if (IN(0)) { prologue(a, lds); } SEAM(0);
    const int wv = __builtin_amdgcn_readfirstlane(threadIdx.x >> 6);
    const int gu_rem = (64 * 22) % G;
#define IDLE_CONVERT(first, last, nbusy) do { if (c0 >= (nbusy)) convert_items(a, lds, (first), (last), (c0 - (nbusy)) * 8 + wv, (G - (nbusy)) * 8); } while (0)
    if (IN(1)) { EpiGU E{SS, ACT}; GEMM(EpiGU, E, HB, WGU, 2 * DFF, D, D, c0); IDLE_CONVERT(cv::E0, cv::E1, gu_rem); } SEAM(1);
    if (IN(2)) { typedef EpiRes<false, false> EpiT; EpiT E{nullptr, nullptr, HB, SS, 0.5f}; GEMM(EpiT, E, ACT, WD, D, DFF, DFF, c0); } SEAM(2);
    if (IN(3)) { EpiConvIn E{SS, (bf16_t*)(ws + WS_VB), (bf16_t*)(ws + WS_BG)}; GEMM(EpiConvIn, E, HB, (const bf16_t*)(ws + WS_WCIN), 3 * D, D, D, c0); } SEAM(3);
    if (IN(4)) { conv_phase(a); } SEAM(4);
    if (IN(5)) { typedef EpiRes<false, false> EpiT; EpiT E{nullptr, nullptr, HB, SS, 1.0f}; GEMM(EpiT, E, (const bf16_t*)(ws + WS_Y), (const bf16_t*)(ws + WS_WCOUT), D, D, D, c0); } SEAM(5);
    if (IN(6)) { EpiGU E{SS, ACT}; GEMM(EpiGU, E, HB, WGU + WGU_ELEMS, 2 * DFF, D, D, c0); IDLE_CONVERT(cv::E1, cv::E2, gu_rem); } SEAM(6);
    if (IN(7)) { typedef EpiRes<false, false> EpiT; EpiT E{nullptr, nullptr, HB, SS, 0.5f}; GEMM(EpiT, E, ACT, WD + WD_ELEMS, D, DFF, DFF, c0); } SEAM(7);
    if (IN(8)) { { EpiKV E{SS, (bf16_t*)(ws + WS_KV), a.k_norm}; GEMM(EpiKV, E, HB, (const bf16_t*)(ws + WS_WKV), NKV, D, D, c0); }
                 { EpiGU E{SS, ACT}; GEMM(EpiGU, E, HB, WGU + 2 * WGU_ELEMS, 2 * DFF, D, D, (c0 + G / 2) % G); } } SEAM(8);
    if (IN(9)) { typedef EpiRes<false, false> EpiT; EpiT E{nullptr, nullptr, HB, SS, 0.5f}; GEMM(EpiT, E, ACT, WD + 2 * WD_ELEMS, D, DFF, DFF, c0); } SEAM(9);
    if (IN(10)) {
        const bool sep = (G >= 128), cmpblk = sep && c0 >= 64 && c0 < 96;
        const int Gq = sep ? G - 32 : G, wq = sep ? (c0 < 64 ? c0 : c0 - 32) : c0;
        if (!cmpblk) { EpiQG E{SS, (bf16_t*)(ws + WS_QB), (float*)(ws + WS_GATE), a.q_norm};
            pg8::Gemm g_{HB, (const bf16_t*)(ws + WS_WQG), M, NQGP, D, D}; pg8::StaticOrder S_; S_.init(M, NQGP, Gq, wq);
            pg8::gemm_phase<EpiQG, pg8::StaticOrder, true, true>(lds, g_, S_, E); }
        if (!sep || cmpblk) {
            for (int slot = 0; slot < 2; ++slot) { EpiHid E{(const float*)(ws + WS_BIASC) + slot * 256, (bf16_t*)(ws + WS_HID) + (size_t)slot * 4096 * 256};
                pg8::Gemm g_{(const bf16_t*)(ws + WS_KV) + (size_t)slot * KVSLOT, (const bf16_t*)(ws + WS_WC1) + (size_t)slot * 256 * 2048, 4096, 256, 2048, 1024};
                pg8::StaticOrder S_; S_.init(4096, 256, G, (c0 + G - 64 - 16 * slot + G) % G);
                pg8::gemm_phase<EpiHid, pg8::StaticOrder, true, true>(lds, g_, S_, E);
                for (int L = (c0 + G - 64 - 16 * slot + G) % G; L < 16; L += G) { const int pmL = (L % 8) * 2 + L / 8; __syncthreads(); cmp2_unit(a, slot, pmL * 8 + wv); } } }
        const int nb2 = (64 * 5) % Gq;
        if (!cmpblk && wq >= nb2) convert_items(a, lds, cv::E2, cv::E4, (wq - nb2) * 8 + wv, (Gq - nb2) * 8);
    } SEAM(10);
    if (IN(12)) { nsa::nsa_phase(a, (LAS char*)lds); } SEAM(12);
    if (IN(13)) { typedef EpiRes<false, false> EpiT; EpiT E{nullptr, nullptr, HB, SS, 1.0f}; GEMM(EpiT, E, (const bf16_t*)(ws + WS_OB), (const bf16_t*)(ws + WS_WO), D, D, D, c0); } SEAM(13);
    if (IN(14)) { EpiGU E{SS, ACT}; GEMM(EpiGU, E, HB, WGU + 3 * WGU_ELEMS, 2 * DFF, D, D, c0); } SEAM(14);
    if (IN(15)) { typedef EpiRes<false, true> EpiT; EpiT E{nullptr, a.out, HB, nullptr, 0.5f}; GEMM(EpiT, E, ACT, WD + 3 * WD_ELEMS, D, DFF, DFF, c0); }
#undef IN
#undef SEAM
#undef GEMM
}

#ifndef PER_PHASE_LAUNCH
#define PER_PHASE_LAUNCH 0
#endif
extern "C" void kernel_launch(void* const* d_in, const int* in_sizes, int n_in, void* d_out, int out_size, void* d_ws, size_t ws_size, hipStream_t stream) {
    static int grid = 0;
    if (grid == 0) {
        if (n_in != 18 || in_sizes[0] != M * D || out_size != M * D || ws_size < WS_END) { fprintf(stderr, "kernel_launch: unexpected problem (n_in %d, in0 %d, out %d, ws %zu)\n", n_in, n_in > 0 ? in_sizes[0] : -1, out_size, ws_size); grid = -1; return; }
        int dev = 0, cus = 0, per_cu = 0;
        if (hipGetDevice(&dev) != hipSuccess || hipDeviceGetAttribute(&cus, hipDeviceAttributeMultiprocessorCount, dev) != hipSuccess) { grid = -1; return; }
        if (hipFuncSetAttribute((const void*)yoco_fwd, hipFuncAttributeMaxDynamicSharedMemorySize, LDS_BYTES) != hipSuccess) { fprintf(stderr, "kernel_launch: hipFuncSetAttribute failed\n"); grid = -1; return; }
        if (hipOccupancyMaxActiveBlocksPerMultiprocessor(&per_cu, (const void*)yoco_fwd, 512, LDS_BYTES) != hipSuccess || per_cu < 1) { fprintf(stderr, "kernel_launch: occupancy query says %d\n", per_cu); per_cu = 1; }
        (void)hipGetLastError();
        grid = cus;
    }
    if (grid < 0) return;
    Args a{};
    const float** ap = (const float**)&a;
    for (int i = 0; i < 18; ++i) ap[i] = (const float*)d_in[i];
    a.out = (float*)d_out; a.ws = (unsigned char*)d_ws;
#if PER_PHASE_LAUNCH
    for (int p = 0; p < NPHASE; ++p) { a.ph_lo = p; a.ph_hi = p + 1; hipLaunchKernelGGL(yoco_fwd, dim3(grid), dim3(512), LDS_BYTES, stream, a); }
#else
    a.ph_lo = 0; a.ph_hi = NPHASE;
    if (hipMemsetAsync(d_ws, 0, 65536, stream) != hipSuccess) { fprintf(stderr, "kernel_launch: memset failed\n"); return; }
    void* args[] = {&a};
    hipError_t e = hipLaunchCooperativeKernel((const void*)yoco_fwd, dim3(grid), dim3(512), args, LDS_BYTES, stream);
    if (e != hipSuccess) fprintf(stderr, "kernel_launch: cooperative launch failed: %s (grid %d)\n", hipGetErrorString(e), grid);
#endif
}
```
